# Optimizing an MI355X kernel written in HIP

```python
import jax, jax.numpy as jnp
from jax import lax
import numpy as np

D_MODEL = 1024
BATCH = 8
SEQ = 2048
DEPTH = 2

MIX_WIDTH = D_MODEL
DN_HEADS = 4
DN_HEAD_K = 128
DN_HEAD_V = 128
DN_K_WIDTH = DN_HEADS * DN_HEAD_K
DN_V_WIDTH = DN_HEADS * DN_HEAD_V
QKV_DIM = 2 * DN_K_WIDTH + DN_V_WIDTH
CONV_WIDTH = 4
DN_CHUNK = 64
GM_GROUPS = 4
GM_GROUP_DIM = 128
GM_WIDTH = GM_GROUPS * GM_GROUP_DIM
GM_CHUNK = 128
D_FF = -(-8 * D_MODEL // (3 * 256)) * 256
EPS = 1e-6

Q_OFF = 0
K_OFF = Q_OFF + DN_K_WIDTH
V_OFF = K_OFF + DN_K_WIDTH
Z_OFF = V_OFF + DN_V_WIDTH
BETA_OFF = Z_OFF + DN_V_WIDTH
A_OFF = BETA_OFF + DN_HEADS
GM_OFF = A_OFF + DN_HEADS
IN_DIM = GM_OFF + 2 * GM_WIDTH

kernel_name = "hybrid_gdn_gmlp_parallel_heads"


def _rmsnorm(x, g):
    xf = x.astype(jnp.float32)
    y = xf * lax.rsqrt(jnp.mean(xf * xf, axis=-1, keepdims=True) + EPS)
    return (y * g.astype(jnp.float32)).astype(x.dtype)


def _l2norm(x):
    return x * lax.rsqrt(jnp.sum(x * x, axis=-1, keepdims=True) + EPS)


def _causal_depthwise_conv(x, w):
    c = x.shape[-1]
    return lax.conv_general_dilated(
        x, w[:, None, :].astype(x.dtype), window_strides=(1,),
        padding=((CONV_WIDTH - 1, 0),), dimension_numbers=("NWC", "WIO", "NWC"),
        feature_group_count=c)


def _gated_delta_rule(q, k, v, g, beta):
    b, t, h, dk = q.shape
    dv = v.shape[-1]
    n = t // DN_CHUNK

    def chunks(a):
        a = jnp.moveaxis(a, 2, 1)
        return a.reshape((b, h, n, DN_CHUNK) + a.shape[3:])

    q, k, v, g, beta = (chunks(a) for a in (q, k, v, g, beta))
    g = jnp.cumsum(g, axis=-1)
    idx = jnp.arange(DN_CHUNK)
    incl = idx[:, None] >= idx[None, :]
    strict = idx[:, None] > idx[None, :]
    diff = g[..., :, None] - g[..., None, :]
    decay = jnp.where(incl, jnp.exp(jnp.where(incl, diff, 0.0)), 0.0)
    k_beta = k * beta[..., None]
    v_beta = v * beta[..., None]
    a_mat = jnp.where(strict, jnp.einsum("bhncd,bhnsd->bhncs", k_beta, k) * decay, 0.0)
    eye = jnp.eye(DN_CHUNK, dtype=a_mat.dtype)
    tri = a_mat + eye
    u = lax.linalg.triangular_solve(tri, v_beta, left_side=True, lower=True)
    w = lax.linalg.triangular_solve(tri, k_beta * jnp.exp(g)[..., None], left_side=True, lower=True)
    qk = jnp.einsum("bhncd,bhnsd->bhncs", q, k) * decay

    def step(s, xs):
        q_c, k_c, u_c, w_c, g_c, qk_c = xs
        v_new = u_c - jnp.einsum("bhcd,bhde->bhce", w_c, s)
        o = (jnp.einsum("bhcd,bhde->bhce", q_c * jnp.exp(g_c)[..., None], s)
             + jnp.einsum("bhcs,bhse->bhce", qk_c, v_new))
        g_last = g_c[..., -1]
        s = (s * jnp.exp(g_last)[..., None, None]
             + jnp.einsum("bhcd,bhce->bhde", k_c * jnp.exp(g_last[..., None] - g_c)[..., None], v_new))
        return s, o

    xs = tuple(jnp.moveaxis(a, 2, 0) for a in (q, k, u, w, g, qk))
    s0 = jnp.zeros((b, h, dk, dv), jnp.float32)
    _, o = lax.scan(step, s0, xs)
    o = jnp.moveaxis(o, 0, 2).reshape(b, h, t, dv)
    return jnp.moveaxis(o, 1, 2)


def _hybrid_mixer(hn, w_in, conv_w, a_log, dt_bias, o_norm_g, ln_v_g, ln_v_b, w_s, b_s, w_out):
    b, t, _ = hn.shape
    proj = hn @ w_in

    qkv = jax.nn.silu(_causal_depthwise_conv(proj[..., Q_OFF:Z_OFF], conv_w)).astype(jnp.float32)
    q = _l2norm(qkv[..., Q_OFF:K_OFF].reshape(b, t, DN_HEADS, DN_HEAD_K)) * (DN_HEAD_K ** -0.5)
    k = _l2norm(qkv[..., K_OFF:V_OFF].reshape(b, t, DN_HEADS, DN_HEAD_K))
    v = qkv[..., V_OFF:Z_OFF].reshape(b, t, DN_HEADS, DN_HEAD_V)
    z = proj[..., Z_OFF:BETA_OFF].astype(jnp.float32).reshape(b, t, DN_HEADS, DN_HEAD_V)
    beta = jax.nn.sigmoid(proj[..., BETA_OFF:A_OFF].astype(jnp.float32))
    g = -jnp.exp(a_log.astype(jnp.float32)) * jax.nn.softplus(
        proj[..., A_OFF:GM_OFF].astype(jnp.float32) + dt_bias.astype(jnp.float32))
    o = _gated_delta_rule(q, k, v, g, beta)
    o = o * lax.rsqrt(jnp.mean(o * o, axis=-1, keepdims=True) + EPS)
    o = o * o_norm_g.astype(jnp.float32) * jax.nn.silu(z)
    o_dn = o.reshape(b, t, DN_V_WIDTH).astype(hn.dtype)

    gm = jax.nn.gelu(proj[..., GM_OFF:IN_DIM])
    u_g = gm[..., :GM_WIDTH]
    v_g = gm[..., GM_WIDTH:].astype(jnp.float32).reshape(b, t, GM_GROUPS, GM_GROUP_DIM)
    mu = jnp.mean(v_g, axis=-1, keepdims=True)
    var = jnp.mean(jnp.square(v_g - mu), axis=-1, keepdims=True)
    v_g = ((v_g - mu) * lax.rsqrt(var + EPS) * ln_v_g.reshape(GM_GROUPS, GM_GROUP_DIM)
           + ln_v_b.reshape(GM_GROUPS, GM_GROUP_DIM)).astype(hn.dtype)
    v_g = v_g.reshape(b, t // GM_CHUNK, GM_CHUNK, GM_GROUPS, GM_GROUP_DIM)
    pos = jnp.arange(GM_CHUNK)
    ws = jnp.where(pos[:, None] >= pos[None, :], w_s, 0.0).astype(hn.dtype)
    sp = jnp.einsum("gts,bnsgc->bntgc", ws, v_g) + b_s.T[:, :, None].astype(hn.dtype)
    o_gm = u_g * sp.reshape(b, t, GM_WIDTH)

    return jnp.concatenate([o_dn, o_gm], axis=-1) @ w_out


def _swiglu(h, w_gate, w_up, w_down):
    return (jax.nn.silu(h @ w_gate) * (h @ w_up)) @ w_down


def setup_inputs(seed: int = 0) -> dict:
    key = jax.random.key(seed)
    ks = jax.random.split(key, 20)
    f32 = jnp.float32
    nrm = lambda k, shape, scale: jax.random.normal(k, shape, f32) * scale
    x = jax.random.normal(ks[0], (BATCH, SEQ, D_MODEL), f32)
    norm_mix = 1.0 + nrm(ks[1], (DEPTH, D_MODEL), 0.02)
    w_in = nrm(ks[2], (DEPTH, D_MODEL, IN_DIM), D_MODEL ** -0.5)
    conv_w = nrm(ks[3], (DEPTH, CONV_WIDTH, QKV_DIM), CONV_WIDTH ** -0.5)
    a_log = jnp.log(jax.random.uniform(ks[4], (DEPTH, DN_HEADS), f32, 1.0, 16.0))
    dt = jnp.exp(jax.random.uniform(ks[5], (DEPTH, DN_HEADS), f32, np.log(1e-3), np.log(1e-1)))
    dt_bias = dt + jnp.log(-jnp.expm1(-dt))
    o_norm_g = 1.0 + nrm(ks[6], (DEPTH, DN_HEAD_V), 0.02)
    ln_v_g = 1.0 + nrm(ks[7], (DEPTH, GM_WIDTH), 0.02)
    ln_v_b = nrm(ks[8], (DEPTH, GM_WIDTH), 0.02)
    w_s = nrm(ks[9], (DEPTH, GM_GROUPS, GM_CHUNK, GM_CHUNK), GM_CHUNK ** -0.5)
    b_s = 1.0 + nrm(ks[10], (DEPTH, GM_GROUPS, GM_CHUNK), 0.02)
    w_out = nrm(ks[11], (DEPTH, MIX_WIDTH, D_MODEL), MIX_WIDTH ** -0.5)
    norm_ffn = 1.0 + nrm(ks[12], (DEPTH, D_MODEL), 0.02)
    w_gate = nrm(ks[13], (DEPTH, D_MODEL, D_FF), D_MODEL ** -0.5)
    w_up = nrm(ks[14], (DEPTH, D_MODEL, D_FF), D_MODEL ** -0.5)
    w_down = nrm(ks[15], (DEPTH, D_FF, D_MODEL), D_FF ** -0.5)
    norm_final = 1.0 + nrm(ks[16], (D_MODEL,), 0.02)
    return {"x": x, "norm_mix": norm_mix, "w_in": w_in, "conv_w": conv_w,
            "a_log": a_log, "dt_bias": dt_bias, "o_norm_g": o_norm_g,
            "ln_v_g": ln_v_g, "ln_v_b": ln_v_b, "w_s": w_s, "b_s": b_s,
            "w_out": w_out, "norm_ffn": norm_ffn, "w_gate": w_gate, "w_up": w_up,
            "w_down": w_down, "norm_final": norm_final}


def reference(x, norm_mix, w_in, conv_w, a_log, dt_bias, o_norm_g, ln_v_g, ln_v_b,
              w_s, b_s, w_out, norm_ffn, w_gate, w_up, w_down, norm_final):
    h = x
    for l in range(DEPTH):
        hn = _rmsnorm(h, norm_mix[l])
        h = h + _hybrid_mixer(hn, w_in[l], conv_w[l], a_log[l], dt_bias[l], o_norm_g[l],
                              ln_v_g[l], ln_v_b[l], w_s[l], b_s[l], w_out[l])
        h = h + _swiglu(_rmsnorm(h, norm_ffn[l]), w_gate[l], w_up[l], w_down[l])
    return _rmsnorm(h, norm_final)
```

```cpp
#include <hip/hip_runtime.h>
#include <cstdio>
#include <cstdint>
namespace pg8 {
#define PG8_LAS __attribute__((address_space(3)))
typedef unsigned short bf16_t;
typedef short bf16x8 __attribute__((ext_vector_type(8)));
typedef float f32x4 __attribute__((ext_vector_type(4)));
typedef unsigned u32x4 __attribute__((ext_vector_type(4)));
constexpr int BM = 256, BK = 64, HALF = 128, HTB = HALF * BK * 2  , STAGE_BYTES = 8 * HTB, NXCD = 8, WGM = 8;

__host__ __device__ __forceinline__ int lds_byte(int r, int c) { const int st = (r >> 4) * 2 + (c >> 5), rr = r & 15, cc = c & 31, ob = rr * 64 + cc * 2; return st * 1024 + (ob ^ (((ob >> 9) & 1) << 5)); }
__host__ __device__ __forceinline__ void stage_rc(int b, int& R, int& C) { const int st = b / 1024, sb = b % 1024, swz = sb ^ (((sb >> 9) & 1) << 5); R = (st >> 1) * 16 + swz / 64; C = (st & 1) * 32 + (swz % 64) / 2; }
__host__ __device__ __forceinline__ int perm32(int rho) { const int n = rho >> 4, i = rho & 15; return 8 * (i >> 2) + 4 * n + (i & 3); }

struct Unit { int pm, pn; };
struct Gemm { const bf16_t* A; const bf16_t* Bt; int M, N, K; };

struct StaticOrder {
    int nM, nN, nwg, G, c;
    __host__ __device__ void init(int M, int N, int G_, int c_) { nM = M / BM; nN = N / BM; nwg = nM * nN; G = G_; c = c_; }
    __host__ __device__ bool next(int i, Unit& u) const {
        const long L = (long)i * G + c; if (L >= nwg) return false;
        int wgid = (int)L; { const int q = nwg / NXCD, r = nwg % NXCD, xcd = wgid % NXCD, off = wgid / NXCD; wgid = (xcd < r ? xcd * (q + 1) : r * (q + 1) + (xcd - r) * q) + off; }
        const int nig = WGM * nN, gid = wgid / nig, fm = gid * WGM, gsz = (nM - fm) < WGM ? (nM - fm) : WGM;
        u.pm = fm + ((wgid % nig) % gsz); u.pn = (wgid % nig) / gsz; return true;
    }
    __device__ __forceinline__ void a_ready(const Unit&) const {}
    __device__ __forceinline__ void done(const Unit&) const {}
};

typedef float f32x2_t __attribute__((ext_vector_type(2))); typedef __bf16 bf16x2_t __attribute__((ext_vector_type(2)));
__device__ __forceinline__ unsigned cvt_pk_bf16(float lo, float hi) { f32x2_t v = {lo, hi}; bf16x2_t b = __builtin_convertvector(v, bf16x2_t); return __builtin_bit_cast(unsigned, b); }
typedef float f32x2 __attribute__((ext_vector_type(2)));
typedef unsigned u32x2 __attribute__((ext_vector_type(2)));
constexpr float RMS_EPS = 1e-6f;
__device__ __forceinline__ float fast_sigmoid(float x) { return __builtin_amdgcn_rcpf(1.0f + __builtin_amdgcn_exp2f(-1.4426950408889634f * x)); }
__device__ __forceinline__ float silu_f(float x) { return x * fast_sigmoid(x); }
__device__ __forceinline__ float gelu_tanh_f(float x) { const float z = 1.5957691216057308f * (x + 0.044715f * x * x * x); return x * fast_sigmoid(z); }
__device__ __forceinline__ float row_rs(const float* ssq, int row) { const f32x4 s = *(const f32x4*)(ssq + (size_t)row * 4); return 1.0f / sqrtf(((s[0] + s[1]) + (s[2] + s[3])) * (1.0f / 1024.0f) + RMS_EPS); }

struct EpiProj {
    static constexpr bool PERM = true, AFTER_DRAIN = false;
    bf16_t* qkv; bf16_t* ocat; bf16_t* vg; const float* ssq;
    __device__ __forceinline__ void operator()(const f32x4 (&acc)[2][2][4][2], const Unit& u, int wr, int wc, int fr, int fq) const {
        const int pn = u.pn; bf16_t* base; int ldc, colt, act;
        if (pn < 6) { base = qkv; ldc = 1536; colt = 256 * pn; act = 0; }
        else if (pn < 8) { base = ocat; ldc = 1024; colt = 256 * (pn - 6); act = 1; }
        else if (pn < 10) { base = ocat; ldc = 1024; colt = 512 + 256 * (pn - 8); act = 2; }
        else { base = vg; ldc = 512; colt = 256 * (pn - 10); act = 2; }
        const int row0 = u.pm * BM + wr * 64 + fr, col0 = colt + wc * 32 + 8 * fq;
#pragma unroll
        for (int ai = 0; ai < 2; ++ai)
#pragma unroll
            for (int m = 0; m < 4; ++m) { const int r = row0 + ai * HALF + m * 16; const float rs = row_rs(ssq, r); bf16_t* rowp = base + (size_t)r * ldc + col0;
#pragma unroll
                for (int bj = 0; bj < 2; ++bj) { f32x4 v0 = acc[ai][bj][m][0] * rs, v1 = acc[ai][bj][m][1] * rs;
                    if (act == 1) {
#pragma unroll
                        for (int e = 0; e < 4; ++e) { v0[e] = silu_f(v0[e]); v1[e] = silu_f(v1[e]); } }
                    else if (act == 2) {
#pragma unroll
                        for (int e = 0; e < 4; ++e) { v0[e] = gelu_tanh_f(v0[e]); v1[e] = gelu_tanh_f(v1[e]); } }
                    u32x4 w; w.x = cvt_pk_bf16(v0[0], v0[1]); w.y = cvt_pk_bf16(v0[2], v0[3]); w.z = cvt_pk_bf16(v1[0], v1[1]); w.w = cvt_pk_bf16(v1[2], v1[3]);
                    *(u32x4*)(rowp + bj * HALF) = w; } }
    }
};

struct EpiSwiglu {
    static constexpr bool PERM = true, AFTER_DRAIN = false;
    bf16_t* hid; const float* ssq;
    __device__ __forceinline__ void operator()(const f32x4 (&acc)[2][2][4][2], const Unit& u, int wr, int wc, int fr, int fq) const {
        const int row0 = u.pm * BM + wr * 64 + fr, col0 = u.pn * HALF + wc * 32 + 8 * fq;
#pragma unroll
        for (int ai = 0; ai < 2; ++ai)
#pragma unroll
            for (int m = 0; m < 4; ++m) { const int r = row0 + ai * HALF + m * 16; const float rs = row_rs(ssq, r);
                f32x4 g0 = acc[ai][0][m][0] * rs, g1 = acc[ai][0][m][1] * rs, u0 = acc[ai][1][m][0] * rs, u1 = acc[ai][1][m][1] * rs;
#pragma unroll
                for (int e = 0; e < 4; ++e) { g0[e] = silu_f(g0[e]) * u0[e]; g1[e] = silu_f(g1[e]) * u1[e]; }
                u32x4 w; w.x = cvt_pk_bf16(g0[0], g0[1]); w.y = cvt_pk_bf16(g0[2], g0[3]); w.z = cvt_pk_bf16(g1[0], g1[1]); w.w = cvt_pk_bf16(g1[2], g1[3]);
                *(u32x4*)(hid + (size_t)r * 2816 + col0) = w; }
    }
};

struct EpiRes {
    static constexpr bool PERM = false, AFTER_DRAIN = true;
    const float* base; float* out; bf16_t* hb; float* ssq;
    __device__ __forceinline__ void fused(f32x4 (&acc)[2][2][4][2], const Unit& u, int wr, int wc, int fr, int fq, PG8_LAS unsigned char* lds, int wid, int lane) const {
        PG8_LAS float* P = (PG8_LAS float*)lds;
        const int col0 = u.pn * BM + wc * 32 + 4 * fq;
#pragma unroll
        for (int ai = 0; ai < 2; ++ai)
#pragma unroll
            for (int m = 0; m < 4; ++m) { const int rl = ai * HALF + wr * 64 + m * 16 + fr; const size_t off = (size_t)(u.pm * BM + rl) * 1024 + col0; float s = 0.f;
#pragma unroll
                for (int bj = 0; bj < 2; ++bj)
#pragma unroll
                    for (int n = 0; n < 2; ++n) { const f32x4 b = *(const f32x4*)(base + off + bj * HALF + n * 16); const f32x4 o = b + acc[ai][bj][m][n];
                        *(f32x4*)(out + off + bj * HALF + n * 16) = o; u32x2 w; w.x = cvt_pk_bf16(o[0], o[1]); w.y = cvt_pk_bf16(o[2], o[3]);
                        *(u32x2*)(hb + off + bj * HALF + n * 16) = w; s += (o[0] * o[0] + o[1] * o[1]) + (o[2] * o[2] + o[3] * o[3]); }
                s += __shfl_xor(s, 16); s += __shfl_xor(s, 32);
                if (fq == 0) P[rl * 4 + wc] = s;
                if (m & 1) asm volatile("" ::: "memory"); }
        asm volatile("s_waitcnt lgkmcnt(0)" ::: "memory"); __builtin_amdgcn_s_barrier(); asm volatile("" ::: "memory");
        const int tid = wid * 64 + lane;
        if (tid < 256) { const float t = (P[tid * 4 + 0] + P[tid * 4 + 1]) + (P[tid * 4 + 2] + P[tid * 4 + 3]); ssq[(size_t)(u.pm * BM + tid) * 4 + u.pn] = t; }
        asm volatile("s_waitcnt lgkmcnt(0)" ::: "memory"); __builtin_amdgcn_s_barrier(); asm volatile("" ::: "memory");
    }
};

template <class Epi, class Sched, bool ALIGN_EPI = false, bool SP2 = false>
__device__ __forceinline__ void gemm_phase(PG8_LAS unsigned char* lds, const Gemm g, const Sched& S, const Epi& E, const int wave_id  ) {
    int tid_ = wave_id * 64 + (int)__builtin_amdgcn_mbcnt_hi(~0u, __builtin_amdgcn_mbcnt_lo(~0u, 0u)); asm volatile("" : "+v"(tid_));
    const int tid = tid_, wid = __builtin_amdgcn_readfirstlane(tid >> 6), lane = tid & 63, wr = wid >> 2, wc = wid & 3, fr = lane & 15, fq = lane >> 4;
    const int K = g.K, nt = K / BK;
    unsigned voffA[2], voffB[2];
#pragma unroll
    for (int i = 0; i < 2; ++i) { int R, C; stage_rc(tid * 16 + i * 8192, R, C); const int Rb = Epi::PERM ? ((R & ~31) + perm32(R & 31)) : R;
        voffA[i] = (unsigned)(R * K + C) * 2u; voffB[i] = (unsigned)(Rb * K + C) * 2u; }
    const size_t kstep = (size_t)(BK * 2);
    const size_t hstep = (size_t)HALF * K * 2;
    const size_t tstep = 2 * hstep;
    const unsigned ldsw = (unsigned)wid * 1024u;
    const int aoff = lds_byte(wr * 64 + fr, fq * 8), boff = lds_byte(wc * 32 + fr, fq * 8);
#define PG8_SA(b, h) (((b) * 2 + (h)) * HTB)
#define PG8_SB(b, h) ((4 + (b) * 2 + (h)) * HTB)
#define PG8_STAGE(bufoff, gbase, voff) do { _Pragma("unroll") for (int _i = 0; _i < 2; ++_i) \
        __builtin_amdgcn_global_load_lds((const unsigned*)((const char*)(gbase) + (voff)[_i]), (PG8_LAS unsigned*)(lds + (bufoff) + ldsw + _i * 8192), 16, 0, 0); } while (0)
#define PG8_LDA(dst, b, h) do { _Pragma("unroll") for (int m = 0; m < 4; ++m) _Pragma("unroll") for (int k = 0; k < 2; ++k) dst[m][k] = *(const PG8_LAS bf16x8*)(lds + PG8_SA(b, h) + aoff + m * 2048 + k * 1024); } while (0)
#define PG8_LDB(dst, b, h) do { _Pragma("unroll") for (int n = 0; n < 2; ++n) _Pragma("unroll") for (int k = 0; k < 2; ++k) dst[n][k] = *(const PG8_LAS bf16x8*)(lds + PG8_SB(b, h) + boff + n * 2048 + k * 1024); } while (0)
#define PG8_MMA(ai, bj, At, Bt) do { __builtin_amdgcn_s_setprio(1); _Pragma("unroll") for (int m = 0; m < 4; ++m) _Pragma("unroll") for (int n = 0; n < 2; ++n) _Pragma("unroll") for (int k = 0; k < 2; ++k) \
        acc[ai][bj][m][n] = __builtin_amdgcn_mfma_f32_16x16x32_bf16(Bt[n][k], At[m][k], acc[ai][bj][m][n], 0, 0, 0); __builtin_amdgcn_s_setprio(0); } while (0)
#define PG8_WAIT_V(n) asm volatile("s_waitcnt vmcnt(" #n ")" ::: "memory")
#define PG8_WAIT_L(n) asm volatile("s_waitcnt lgkmcnt(" #n ")" ::: "memory")
#define PG8_BAR __builtin_amdgcn_s_barrier()
#define PG8_SCHED __builtin_amdgcn_sched_barrier(0)
    Unit cur, nxt; int ui = 0;
    if (!S.next(0, cur)) return;
    f32x4 acc[2][2][4][2];
#pragma unroll
    for (int a = 0; a < 2; ++a)
#pragma unroll
        for (int b = 0; b < 2; ++b)
#pragma unroll
            for (int m = 0; m < 4; ++m)
#pragma unroll
                for (int n = 0; n < 2; ++n) acc[a][b][m][n] = (f32x4){0.f, 0.f, 0.f, 0.f};
    bf16x8 At[4][2], B0[2][2], B1[2][2];
    const char* cA = (const char*)g.A + (size_t)cur.pm * tstep; const char* cB = (const char*)g.Bt + (size_t)cur.pn * tstep;
    S.a_ready(cur);
    if constexpr (SP2) {
        PG8_STAGE(PG8_SB(0, 0), cB, voffB); PG8_STAGE(PG8_SB(0, 1), cB + hstep, voffB); PG8_STAGE(PG8_SA(0, 0), cA, voffA); PG8_STAGE(PG8_SA(0, 1), cA + hstep, voffA);
        if (wr == 1) PG8_BAR;
        PG8_WAIT_V(2); PG8_BAR;
        PG8_STAGE(PG8_SB(1, 0), cB + kstep, voffB); PG8_STAGE(PG8_SA(1, 0), cA + kstep, voffA); PG8_STAGE(PG8_SB(1, 1), cB + hstep + kstep, voffB);
        PG8_WAIT_V(6); PG8_BAR;
    } else {
        PG8_STAGE(PG8_SB(0, 0), cB, voffB); PG8_STAGE(PG8_SA(0, 0), cA, voffA); PG8_STAGE(PG8_SB(0, 1), cB + hstep, voffB); PG8_STAGE(PG8_SA(0, 1), cA + hstep, voffA);
        if (wr == 1) PG8_BAR;
        PG8_WAIT_V(4); PG8_BAR;
        PG8_STAGE(PG8_SB(1, 0), cB + kstep, voffB); PG8_STAGE(PG8_SA(1, 0), cA + kstep, voffA); PG8_STAGE(PG8_SB(1, 1), cB + hstep + kstep, voffB);
        PG8_WAIT_V(6); PG8_BAR;
    }
    for (;;) {
        const bool has_next = S.next(ui + 1, nxt);
        const char* nA = has_next ? (const char*)g.A + (size_t)nxt.pm * tstep : cA; const char* nB = has_next ? (const char*)g.Bt + (size_t)nxt.pn * tstep : cB;
        for (int t = 0; t < nt; t += 2) {
            const bool last = (t == nt - 2);
            const char* a1 = cA + (size_t)(t + 1) * kstep;
            const char* a2 = last ? nA : cA + (size_t)(t + 2) * kstep; const char* b2 = last ? nB : cB + (size_t)(t + 2) * kstep;
            const char* a3 = a2 + kstep; const char* b3 = b2 + kstep;
            if (last && has_next) S.a_ready(nxt);
            if constexpr (SP2) {
            PG8_LDB(B0, 0, 0); PG8_LDB(B1, 0, 1); PG8_SCHED; PG8_LDA(At, 0, 0); PG8_STAGE(PG8_SA(1, 1), a1 + hstep, voffA);
            PG8_WAIT_V(8); PG8_WAIT_L(0); PG8_BAR; PG8_MMA(0, 0, At, B0); PG8_MMA(0, 1, At, B1); PG8_BAR; PG8_SCHED;
            PG8_LDA(At, 0, 1); PG8_STAGE(PG8_SB(0, 0), b2, voffB); PG8_STAGE(PG8_SB(0, 1), b2 + hstep, voffB); PG8_STAGE(PG8_SA(0, 0), a2, voffA);
            PG8_WAIT_V(8); PG8_WAIT_L(0); PG8_BAR; PG8_MMA(1, 0, At, B0); PG8_MMA(1, 1, At, B1); PG8_BAR; PG8_SCHED;
            PG8_LDB(B0, 1, 0); PG8_LDB(B1, 1, 1); PG8_SCHED; PG8_LDA(At, 1, 0); PG8_STAGE(PG8_SA(0, 1), a2 + hstep, voffA);
            PG8_WAIT_V(8); PG8_WAIT_L(0); PG8_BAR; PG8_MMA(0, 0, At, B0); PG8_MMA(0, 1, At, B1); PG8_BAR; PG8_SCHED;
            PG8_LDA(At, 1, 1); PG8_STAGE(PG8_SB(1, 0), b3, voffB); PG8_STAGE(PG8_SB(1, 1), b3 + hstep, voffB); PG8_STAGE(PG8_SA(1, 0), a3, voffA);
            PG8_WAIT_V(8); PG8_WAIT_L(0); PG8_BAR; PG8_MMA(1, 0, At, B0); PG8_MMA(1, 1, At, B1); PG8_BAR; PG8_SCHED;
            } else {
            PG8_LDB(B0, 0, 0); PG8_SCHED; PG8_LDA(At, 0, 0); PG8_STAGE(PG8_SA(1, 1), a1 + hstep, voffA);
            PG8_WAIT_L(8); PG8_BAR; PG8_WAIT_L(0); PG8_MMA(0, 0, At, B0); PG8_BAR; PG8_SCHED;
            PG8_LDB(B1, 0, 1); PG8_STAGE(PG8_SB(0, 0), b2, voffB);
            PG8_BAR; PG8_WAIT_L(0); PG8_MMA(0, 1, At, B1); PG8_BAR;
            PG8_LDA(At, 0, 1); PG8_STAGE(PG8_SA(0, 0), a2, voffA);
            PG8_BAR; PG8_WAIT_L(0); PG8_MMA(1, 0, At, B0); PG8_BAR; PG8_SCHED;
            PG8_STAGE(PG8_SB(0, 1), b2 + hstep, voffB);
            PG8_WAIT_V(6); PG8_BAR; PG8_MMA(1, 1, At, B1); PG8_BAR;
            PG8_LDB(B0, 1, 0); PG8_SCHED; PG8_LDA(At, 1, 0); PG8_STAGE(PG8_SA(0, 1), a2 + hstep, voffA);
            PG8_WAIT_L(8); PG8_BAR; PG8_WAIT_L(0); PG8_MMA(0, 0, At, B0); PG8_BAR; PG8_SCHED;
            PG8_LDB(B1, 1, 1); PG8_STAGE(PG8_SB(1, 0), b3, voffB);
            PG8_BAR; PG8_WAIT_L(0); PG8_MMA(0, 1, At, B1); PG8_BAR;
            PG8_LDA(At, 1, 1); PG8_STAGE(PG8_SA(1, 0), a3, voffA);
            PG8_BAR; PG8_WAIT_L(0); PG8_MMA(1, 0, At, B0); PG8_BAR; PG8_SCHED;
            PG8_STAGE(PG8_SB(1, 1), b3 + hstep, voffB);
            PG8_WAIT_V(6); PG8_BAR; PG8_MMA(1, 1, At, B1); PG8_BAR;
            }
        }
        if constexpr (ALIGN_EPI) { if (wr == 0) PG8_BAR; }
        if constexpr (!Epi::AFTER_DRAIN) { E(acc, cur, wr, wc, fr, fq); S.done(cur); }
        if (!has_next) break;
#pragma unroll
        for (int a = 0; a < 2; ++a)
#pragma unroll
            for (int b = 0; b < 2; ++b)
#pragma unroll
                for (int m = 0; m < 4; ++m)
#pragma unroll
                    for (int n = 0; n < 2; ++n) acc[a][b][m][n] = (f32x4){0.f, 0.f, 0.f, 0.f};
        cur = nxt; cA = nA; cB = nB; ++ui;
        if constexpr (ALIGN_EPI) { if (wr == 1) PG8_BAR; }
    }
    PG8_WAIT_V(0);
    if constexpr (!ALIGN_EPI) { if (wr == 0) PG8_BAR; }
    PG8_BAR;
    if constexpr (Epi::AFTER_DRAIN) { E.fused(acc, cur, wr, wc, fr, fq, lds, wid, lane); S.done(cur); }
#undef PG8_SA
#undef PG8_SB
#undef PG8_STAGE
#undef PG8_LDA
#undef PG8_LDB
#undef PG8_MMA
#undef PG8_WAIT_V
#undef PG8_WAIT_L
#undef PG8_BAR
#undef PG8_SCHED
}
}

constexpr int NWAVES = 8;
#ifndef MK_N_LAUNCHES
#define MK_N_LAUNCHES 1
#endif
constexpr int N_PHASES = 12;
constexpr int BATCH = 8, T = 2048, D = 1024, M = BATCH * T, DEPTH = 2;
constexpr int NPROJ = 3072, IN_DIM = 3080, QKV = 1536, DFF = 2816, NGU = 2 * DFF;
constexpr int NH = 4, DK = 128, CH = 64, NCH = T / CH;
constexpr int GMC = 128;
constexpr size_t WS_CTL = 0, CTL_BYTES = 1u << 20;
constexpr size_t SZ_WIN = (size_t)NPROJ * D * 2, SZ_WBA = 16 * D * 2, SZ_WOUT = (size_t)D * D * 2, SZ_WGU = (size_t)NGU * D * 2, SZ_WDN = (size_t)D * DFF * 2, SZ_WSB = 4 * 128 * 128 * 2;
constexpr size_t SZ_WL = SZ_WIN + SZ_WBA + SZ_WOUT + SZ_WGU + SZ_WDN + SZ_WSB;
constexpr size_t WS_W = WS_CTL + CTL_BYTES;
constexpr size_t OFF_WIN = 0, OFF_WBA = OFF_WIN + SZ_WIN, OFF_WOUT = OFF_WBA + SZ_WBA, OFF_WGU = OFF_WOUT + SZ_WOUT, OFF_WDN = OFF_WGU + SZ_WGU, OFF_WSB = OFF_WDN + SZ_WDN;
constexpr size_t WS_BG = WS_W + DEPTH * SZ_WL;
constexpr size_t WS_SSQ = WS_BG + (size_t)M * 8 * 4;
constexpr size_t WS_HB = WS_SSQ + (size_t)M * 4 * 4;
constexpr size_t WS_R = WS_HB + (size_t)M * D * 2;
constexpr size_t WS_QKV = WS_R;
constexpr size_t WS_OCAT = WS_QKV + (size_t)M * QKV * 2;
constexpr size_t WS_VG = WS_OCAT + (size_t)M * D * 2;
constexpr size_t WS_RING = WS_VG + (size_t)M * 512 * 2;
constexpr size_t WS_HID = WS_R;
constexpr int SL_WN = 0, SL_QG = 16384, SL_KGT = 32768, SL_QK = 49152, SL_UT = 57344, SL_MISC = 73728, SLOT_BYTES = 73984;
constexpr size_t WS_SSAVE = WS_RING + (size_t)32 * NCH * SLOT_BYTES;
constexpr size_t WS_END = WS_SSAVE + (size_t)32 * 512 * 128;
static_assert((size_t)M * DFF * 2 <= WS_RING - WS_R, "hidden overlay fits");
static_assert(WS_END <= 268435456ull, "d_ws map fits 256 MiB");
constexpr int CW_BAR = 4096;
constexpr int CW_FLAG = 16384;
static_assert((CW_FLAG + 2 * 32 * 32 * 16) * 4 <= (int)CTL_BYTES, "ctl words");
constexpr int RING_BYTES = 131072, MISC_OFF = RING_BYTES + 320, LDS_BYTES = 147456;

#define GAS __attribute__((address_space(1)))
#define LAS __attribute__((address_space(3)))
typedef unsigned short bf16;
typedef unsigned v4u __attribute__((ext_vector_type(4)));
typedef unsigned v2u __attribute__((ext_vector_type(2)));
typedef float f32x4 __attribute__((ext_vector_type(4)));
typedef float f32x2 __attribute__((ext_vector_type(2)));
typedef short bf16x8 __attribute__((ext_vector_type(8)));
typedef short bf16x4 __attribute__((ext_vector_type(4)));
typedef GAS unsigned gu32;
#define RLX_AGENT __ATOMIC_RELAXED, __HIP_MEMORY_SCOPE_AGENT
#define LDS_WAIT() asm volatile("s_waitcnt lgkmcnt(0)" ::: "memory")
#define VM_WAIT() asm volatile("s_waitcnt vmcnt(0)" ::: "memory")
__device__ __forceinline__ unsigned pk2(float lo, float hi) { return pg8::cvt_pk_bf16(lo, hi); }
__device__ __forceinline__ float bf_lo(unsigned u) { return __uint_as_float(u << 16); }
__device__ __forceinline__ float bf_hi(unsigned u) { return __uint_as_float(u & 0xffff0000u); }
__device__ __forceinline__ float bf2f(unsigned short s) { return __uint_as_float((unsigned)s << 16); }
__device__ __forceinline__ float wave_sum(float v) {
#pragma unroll
    for (int o = 1; o < 64; o <<= 1) v += __shfl_xor(v, o);
    return v;
}
__device__ __forceinline__ bf16x8 mk8(v2u a, v2u b) { v4u t; t.x = a.x; t.y = a.y; t.z = b.x; t.w = b.y; return __builtin_bit_cast(bf16x8, t); }
__device__ __forceinline__ v2u pk4(f32x4 v) { v2u r; r.x = pk2(v[0], v[1]); r.y = pk2(v[2], v[3]); return r; }
__device__ __forceinline__ v2u pk4n(f32x4 v) { v2u r; r.x = pk2(-v[0], -v[1]); r.y = pk2(-v[2], -v[3]); return r; }
#define MFMA16(a, b, c) __builtin_amdgcn_mfma_f32_16x16x32_bf16((a), (b), (c), 0, 0, 0)

#define XB_TMO      128
#define XB_XCNT(j)  (256  + 64 * (j))
#define XB_XSUB(j)  (1280 + 64 * (j))
#define XB_XGEN(j)  (2304 + 64 * (j))
#define XB_TOP      3328
#define XB_TOPGEN   3392
#define XCD_BAR_WORDS 3456
#define XB_SPIN_CAP (1u << 18)
__device__ __forceinline__ unsigned xb_ld(unsigned* p)              { return __hip_atomic_load(p, __ATOMIC_RELAXED, __HIP_MEMORY_SCOPE_AGENT); }
__device__ __forceinline__ unsigned xb_add(unsigned* p, unsigned v) { return __hip_atomic_fetch_add(p, v, __ATOMIC_RELAXED, __HIP_MEMORY_SCOPE_AGENT); }
__device__ __forceinline__ unsigned xb_xcc_id() { return (unsigned)__builtin_amdgcn_s_getreg((3 << 11) | 20) & 0xFu; }
#define XB_SPIN(cond, bar) do { unsigned _sp = 0; while (cond) { __builtin_amdgcn_s_sleep(1); \
    if ((++_sp & 255u) == 0u) { if (xb_ld(&(bar)[XB_TMO])) break; if (_sp > XB_SPIN_CAP) { atomicAdd(&(bar)[XB_TMO], 1u); break; } } } } while (0)
struct XcdBarrier { unsigned* bar; unsigned x; volatile LAS unsigned* st; };
__device__ __forceinline__ XcdBarrier xcd_barrier_post(unsigned* bar, volatile LAS unsigned* st) {
    XcdBarrier b; b.bar = bar; b.x = xb_xcc_id(); b.st = st;
    if (threadIdx.x == 0) (void)xb_add(&bar[XB_XCNT(b.x)], 1u);
    return b;
}
__device__ __forceinline__ void xcd_barrier_complete(unsigned* bar, unsigned x, unsigned& nloc, unsigned& nx) {
    const unsigned G = gridDim.x * gridDim.y * gridDim.z;
    unsigned sum, cnt, mine, sp = 0u;
    for (;;) {
        sum = 0u; cnt = 0u; mine = 0u;
#pragma unroll
        for (unsigned j = 0; j < 16; ++j) { const unsigned c = xb_ld(&bar[XB_XCNT(j)]); sum += c; cnt += (c > 0u) ? 1u : 0u; mine = (j == x) ? c : mine; }
        if (sum == G) break;
        __builtin_amdgcn_s_sleep(1);
        if ((++sp & 255u) == 0u) { if (xb_ld(&bar[XB_TMO])) break; if (sp > XB_SPIN_CAP) { atomicAdd(&bar[XB_TMO], 1u); break; } }
    }
    nloc = mine > 0u ? mine : 1u; nx = cnt > 0u ? cnt : 1u;
}
__device__ __forceinline__ void xcd_barrier(const XcdBarrier& b, const int wave_id) {
    asm volatile("s_waitcnt vmcnt(0)" ::: "memory");
    __syncthreads();
    if (wave_id == 0 && __builtin_amdgcn_mbcnt_hi(~0u, __builtin_amdgcn_mbcnt_lo(~0u, 0u)) == 0u) {
        unsigned* bar = b.bar;
        __builtin_amdgcn_s_waitcnt(0);
        unsigned nloc = b.st[0], nx = b.st[1];
        if (nloc == 0u) { xcd_barrier_complete(bar, b.x, nloc, nx); b.st[0] = nloc; b.st[1] = nx; }
        const unsigned old = xb_add(&bar[XB_XSUB(b.x)], 1u);
        const unsigned gen = old / nloc;
        if (old + 1u == (gen + 1u) * nloc) {
            __builtin_amdgcn_fence(__ATOMIC_RELEASE, "agent");
            asm volatile("s_waitcnt vmcnt(0)" ::: "memory");
            const unsigned og = xb_add(&bar[XB_TOP], 1u);
            const unsigned tg = og / nx;
            if (og + 1u == (tg + 1u) * nx) xb_add(&bar[XB_TOPGEN], 1u);
            else XB_SPIN(xb_ld(&bar[XB_TOPGEN]) == tg, bar);
            __builtin_amdgcn_fence(__ATOMIC_ACQUIRE, "agent");
            xb_add(&bar[XB_XGEN(b.x)], 1u);
            asm volatile("s_waitcnt vmcnt(0)" ::: "memory");
        } else {
            XB_SPIN(xb_ld(&bar[XB_XGEN(b.x)]) == gen, bar);
            __builtin_amdgcn_fence(__ATOMIC_ACQUIRE, "agent");
            asm volatile("s_waitcnt vmcnt(0)" ::: "memory");
        }
    }
    __syncthreads();
}

struct Args { const float* in[17]; float* out; unsigned char* ws; int ph_lo, ph_hi; };
#define CAS __attribute__((address_space(4)))
struct Frame {
    LAS unsigned char* lds;
    int tid, lane, wave, G, vcu;
    const CAS Args* A;
};
struct LayerW { bf16 *win, *wba, *wout, *wgu, *wdn, *wsb; };
__device__ __forceinline__ LayerW layer_w(unsigned char* ws, int l) {
    unsigned char* b = ws + WS_W + (size_t)l * SZ_WL; LayerW w;
    w.win = (bf16*)(b + OFF_WIN); w.wba = (bf16*)(b + OFF_WBA); w.wout = (bf16*)(b + OFF_WOUT); w.wgu = (bf16*)(b + OFF_WGU); w.wdn = (bf16*)(b + OFF_WDN); w.wsb = (bf16*)(b + OFF_WSB);
    return w;
}

__device__ __forceinline__ void p0_transpose_item(const float* W, int K, int N, int k0, int nsrc0, bf16* WT, int drow0, const float* scale, LAS float* scr, int lane) {
#pragma unroll 8
    for (int i = 0; i < 32; ++i) { const int kk = 2 * i + (lane >> 5); float v = W[(size_t)(k0 + kk) * N + nsrc0 + (lane & 31)]; if (scale) v *= scale[k0 + kk]; scr[kk * 33 + (lane & 31)] = v; }
    LDS_WAIT(); asm volatile("" ::: "memory");
    const int c = lane & 7;
#pragma unroll
    for (int j = 0; j < 4; ++j) { const int n = (lane >> 3) + 8 * j; const LAS float* s = scr + (8 * c) * 33 + n;
        v4u o; o.x = pk2(s[0 * 33], s[1 * 33]); o.y = pk2(s[2 * 33], s[3 * 33]); o.z = pk2(s[4 * 33], s[5 * 33]); o.w = pk2(s[6 * 33], s[7 * 33]);
        *(GAS v4u*)(WT + (size_t)(drow0 + n) * K + k0 + 8 * c) = o; }
    LDS_WAIT(); asm volatile("" ::: "memory");
}
__device__ __forceinline__ void p0_prologue(Frame& F) {
    LAS float* scr = (LAS float*)(F.lds + F.wave * 16384);
    const int gw = F.vcu * NWAVES + F.wave, NGW = F.G * NWAVES;
    constexpr int I_IN = (D / 64) * (NPROJ / 32), I_OUT = (D / 64) * (D / 32), I_GU = (D / 64) * (NGU / 32), I_DN = (DFF / 64) * (D / 32), I_L = I_IN + I_OUT + I_GU + I_DN;
    for (int it = gw; it < DEPTH * I_L; it += NGW) {
        const int l = it / I_L; int r = it % I_L; const LayerW w = layer_w(F.A->ws, l);
        if (r < I_IN) { const int nb = r % (NPROJ / 32), kb = r / (NPROJ / 32); const int nd = nb * 32, ns = nd + (nd >= 2048 ? 8 : 0);
            p0_transpose_item(F.A->in[2] + (size_t)l * D * IN_DIM, D, IN_DIM, kb * 64, ns, w.win, nd, F.A->in[1] + l * D, scr, F.lane); continue; } r -= I_IN;
        if (r < I_OUT) { const int nb = r % (D / 32), kb = r / (D / 32);
            p0_transpose_item(F.A->in[11] + (size_t)l * D * D, D, D, kb * 64, nb * 32, w.wout, nb * 32, nullptr, scr, F.lane); continue; } r -= I_OUT;
        if (r < I_GU) { const int nb = r % (NGU / 32), kb = r / (NGU / 32); const int tile = nb >> 3, j = nb & 7;
            const float* src = (j < 4 ? F.A->in[13] : F.A->in[14]) + (size_t)l * D * DFF;
            p0_transpose_item(src, D, DFF, kb * 64, tile * 128 + (j & 3) * 32, w.wgu, nb * 32, F.A->in[12] + l * D, scr, F.lane); continue; } r -= I_GU;
        { const int nb = r % (D / 32), kb = r / (D / 32);
            p0_transpose_item(F.A->in[15] + (size_t)l * DFF * D, DFF, D, kb * 64, nb * 32, w.wdn, nb * 32, nullptr, scr, F.lane); }
    }
    const int gt = F.vcu * (NWAVES * 64) + F.tid, NGT = F.G * NWAVES * 64;
    for (int i = gt; i < DEPTH * 16 * D; i += NGT) { const int l = i / (16 * D), j = (i / D) & 15, k = i % D;
        const float v = j < 8 ? F.A->in[2][(size_t)l * D * IN_DIM + (size_t)k * IN_DIM + 2048 + j] * F.A->in[1][l * D + k] : 0.f;
        layer_w(F.A->ws, l).wba[j * D + k] = (bf16)(pk2(v, 0.f) & 0xffffu); }
    for (int i = gt; i < DEPTH * 4 * 128 * 128; i += NGT) { const int l = i / (4 * 128 * 128), e = i % (4 * 128 * 128), t = (e >> 7) & 127, s = e & 127;
        const float v = (t >= s) ? F.A->in[9][i] : 0.f; layer_w(F.A->ws, l).wsb[e] = (bf16)(pk2(v, 0.f) & 0xffffu); }
    bf16* hb = (bf16*)(F.A->ws + WS_HB); float* ssq = (float*)(F.A->ws + WS_SSQ);
    for (int m = gw; m < M; m += NGW) {
        const GAS f32x4* xr = (const GAS f32x4*)(F.A->in[0] + (size_t)m * D) + F.lane; f32x4 v[4]; float s = 0.f;
#pragma unroll
        for (int j = 0; j < 4; ++j) { v[j] = xr[64 * j]; s += (v[j].x * v[j].x + v[j].y * v[j].y) + (v[j].z * v[j].z + v[j].w * v[j].w); }
        s = wave_sum(s);
        GAS v2u* o8 = (GAS v2u*)(hb + (size_t)m * D) + F.lane;
#pragma unroll
        for (int j = 0; j < 4; ++j) { v2u o; o.x = pk2(v[j].x, v[j].y); o.y = pk2(v[j].z, v[j].w); o8[64 * j] = o; }
        if (F.lane == 0) *(GAS f32x4*)(ssq + (size_t)m * 4) = (f32x4){s, 0.f, 0.f, 0.f};
    }
}

__device__ __forceinline__ void ba_rows(Frame& F, int l, int row0) {
    const bf16* hb = (const bf16*)(F.A->ws + WS_HB); const bf16* wba = layer_w(F.A->ws, l).wba; const float* ssq = (const float*)(F.A->ws + WS_SSQ); float* bg = (float*)(F.A->ws + WS_BG);
    const int fr = F.lane & 15, fq = F.lane >> 4, w = F.wave;
    f32x4 acc[4];
#pragma unroll
    for (int m = 0; m < 4; ++m) acc[m] = (f32x4){0.f, 0.f, 0.f, 0.f};
#pragma unroll
    for (int ks = 0; ks < 4; ++ks) { const int k0 = 128 * w + 32 * ks + 8 * fq;
        const bf16x8 b = *(const GAS bf16x8*)(wba + (size_t)fr * D + k0);
#pragma unroll
        for (int m = 0; m < 4; ++m) { const bf16x8 a = *(const GAS bf16x8*)(hb + (size_t)(row0 + 16 * m + fr) * D + k0); acc[m] = MFMA16(a, b, acc[m]); } }
    LAS float* part = (LAS float*)F.lds;
#pragma unroll
    for (int m = 0; m < 4; ++m)
#pragma unroll
        for (int r = 0; r < 4; ++r) part[(w * 64 + 16 * m + 4 * fq + r) * 16 + fr] = acc[m][r];
    LDS_WAIT(); __syncthreads();
    { const int row = F.tid >> 3, j = F.tid & 7; float s = 0.f;
#pragma unroll
      for (int ww = 0; ww < 8; ++ww) s += part[(ww * 64 + row) * 16 + j];
      s *= pg8::row_rs(ssq, row0 + row);
      float o;
      if (j < 4) o = 1.0f / (1.0f + __expf(-s));
      else { const float z = s + F.A->in[5][l * 4 + (j - 4)]; const float sp = z > 20.f ? z : log1pf(__expf(z)); o = -__expf(F.A->in[4][l * 4 + (j - 4)]) * sp; }
      bg[(size_t)(row0 + row) * 8 + j] = o; }
    __syncthreads();
}

constexpr int PK_KB = 0, PK_QB = 17408, PK_VT = 34816, PK_KT = 69632, PK_AF = 104448, PK_TD = 121856, PK_GC = 124928;
constexpr int SC_W = 0, SC_Q = 17408, SC_K = 34816, SC_QK = 53248, SC_O = 62464;

__device__ __forceinline__ void delta_prep_item(Frame& F, int l, int b, int h, int n, unsigned char* slot) {
    const bf16* qkv = (const bf16*)(F.A->ws + WS_QKV); const float* bg = (const float*)(F.A->ws + WS_BG); const float* convw = F.A->in[3] + (size_t)l * 4 * QKV;
    LAS unsigned char* L = F.lds; int lane_ = F.lane; asm volatile("" : "+v"(lane_));
    const int lane = lane_, w = F.wave, tid = w * 64 + lane, fr = lane & 15, fq = lane >> 4;
    const int t0 = n * CH, R0 = b * T + t0;
    float gc, bval;
    { const float gv = bg[(size_t)(R0 + lane) * 8 + 4 + h]; bval = bg[(size_t)(R0 + lane) * 8 + h]; gc = gv;
#pragma unroll
      for (int o = 1; o < 64; o <<= 1) { const float t = __shfl_up(gc, o); if (lane >= o) gc += t; } }
    const float glast = __shfl(gc, 63);
    if (w == 0) { ((LAS float*)(L + PK_GC))[lane] = gc; ((LAS float*)(L + PK_GC))[64 + lane] = bval; }
    float eg[8], ek[8], be[8];
#pragma unroll
    for (int i = 0; i < 8; ++i) { const float g_i = __shfl(gc, 8 * w + i); eg[i] = __expf(g_i); ek[i] = __expf(glast - g_i); be[i] = __shfl(bval, 8 * w + i); }
#ifndef SK_A
    const int ch = 2 * lane;
#pragma unroll 1
    for (int X = 0; X < 3; ++X) { const int XX = (X == 0) ? 1 : (X == 1 ? 0 : 2);
        const int colx = XX * 512 + h * 128 + ch;
        float cw0[4], cw1[4];
#pragma unroll
        for (int j = 0; j < 4; ++j) { const f32x2 c2 = *(const GAS f32x2*)(convw + (size_t)j * QKV + colx); cw0[j] = c2.x; cw1[j] = c2.y; }
        float x0[11], x1[11];
#pragma unroll
        for (int rr = 0; rr < 11; ++rr) { const int tt = t0 + 8 * w + rr - 3; unsigned u = 0u; if (tt >= 0) u = *(const GAS unsigned*)(qkv + (size_t)(R0 + 8 * w + rr - 3) * QKV + colx); x0[rr] = bf_lo(u); x1[rr] = bf_hi(u); }
        float y0[8], y1[8];
#pragma unroll
        for (int i = 0; i < 8; ++i) { float a0 = 0.f, a1 = 0.f;
#pragma unroll
            for (int j = 0; j < 4; ++j) { a0 += cw0[j] * x0[i + j]; a1 += cw1[j] * x1[i + j]; }
            y0[i] = pg8::silu_f(a0); y1[i] = pg8::silu_f(a1); }
        if (XX < 2) {
#pragma unroll
            for (int i = 0; i < 8; ++i) { const float sq = wave_sum(y0[i] * y0[i] + y1[i] * y1[i]); const float rn = (XX == 0 ? 0.08838834764831845f : 1.0f) / sqrtf(sq + 1e-6f); y0[i] *= rn; y1[i] *= rn; } }
        if (XX == 0) {
#pragma unroll
            for (int i = 0; i < 8; ++i) { const int c = 8 * w + i;
                *(LAS unsigned*)(L + PK_QB + c * 272 + ch * 2) = pk2(y0[i], y1[i]);
                *(GAS unsigned*)(slot + SL_QG + (c * 128 + ch) * 2) = pk2(y0[i] * eg[i], y1[i] * eg[i]); }
        } else if (XX == 1) {
#pragma unroll
            for (int i = 0; i < 8; ++i) { const int c = 8 * w + i; *(LAS unsigned*)(L + PK_KB + c * 272 + ch * 2) = pk2(y0[i], y1[i]); }
            { v4u kg; kg.x = pk2(y0[0] * ek[0], y0[1] * ek[1]); kg.y = pk2(y0[2] * ek[2], y0[3] * ek[3]); kg.z = pk2(y0[4] * ek[4], y0[5] * ek[5]); kg.w = pk2(y0[6] * ek[6], y0[7] * ek[7]);
              *(GAS v4u*)(slot + SL_KGT + ((ch) * 64 + 8 * w) * 2) = kg;
              kg.x = pk2(y1[0] * ek[0], y1[1] * ek[1]); kg.y = pk2(y1[2] * ek[2], y1[3] * ek[3]); kg.z = pk2(y1[4] * ek[4], y1[5] * ek[5]); kg.w = pk2(y1[6] * ek[6], y1[7] * ek[7]);
              *(GAS v4u*)(slot + SL_KGT + ((ch + 1) * 64 + 8 * w) * 2) = kg; }
            LAS float* kt = (LAS float*)(L + PK_KT + ch * 272 + 8 * w * 4);
            *(LAS f32x4*)kt = (f32x4){y0[0] * be[0] * eg[0], y0[1] * be[1] * eg[1], y0[2] * be[2] * eg[2], y0[3] * be[3] * eg[3]};
            *(LAS f32x4*)(kt + 4) = (f32x4){y0[4] * be[4] * eg[4], y0[5] * be[5] * eg[5], y0[6] * be[6] * eg[6], y0[7] * be[7] * eg[7]};
            *(LAS f32x4*)(kt + 68) = (f32x4){y1[0] * be[0] * eg[0], y1[1] * be[1] * eg[1], y1[2] * be[2] * eg[2], y1[3] * be[3] * eg[3]};
            *(LAS f32x4*)(kt + 72) = (f32x4){y1[4] * be[4] * eg[4], y1[5] * be[5] * eg[5], y1[6] * be[6] * eg[6], y1[7] * be[7] * eg[7]};
        } else {
            LAS float* vt = (LAS float*)(L + PK_VT + ch * 272 + 8 * w * 4);
            *(LAS f32x4*)vt = (f32x4){y0[0] * be[0], y0[1] * be[1], y0[2] * be[2], y0[3] * be[3]};
            *(LAS f32x4*)(vt + 4) = (f32x4){y0[4] * be[4], y0[5] * be[5], y0[6] * be[6], y0[7] * be[7]};
            *(LAS f32x4*)(vt + 68) = (f32x4){y1[0] * be[0], y1[1] * be[1], y1[2] * be[2], y1[3] * be[3]};
            *(LAS f32x4*)(vt + 72) = (f32x4){y1[4] * be[4], y1[5] * be[5], y1[6] * be[6], y1[7] * be[7]};
        }
        asm volatile("" ::: "memory");
    }
#endif
    if (tid == 0) *(GAS float*)(slot + SL_MISC) = __expf(glast);
    LDS_WAIT(); __syncthreads();
    const LAS float* GC = (const LAS float*)(L + PK_GC); const LAS float* BE = GC + 64;
#ifndef SK_B1
    for (int fi = w; fi < 10; fi += 8) { const int mb = fi >= 6 ? 3 : (fi >= 3 ? 2 : (fi >= 1 ? 1 : 0)), sb = fi - (mb * (mb + 1)) / 2;
        f32x4 acc = (f32x4){0.f, 0.f, 0.f, 0.f};
#pragma unroll
        for (int ks = 0; ks < 4; ++ks) { const bf16x8 a = *(const LAS bf16x8*)(L + PK_KB + (16 * mb + fr) * 272 + (32 * ks + 8 * fq) * 2); const bf16x8 bb = *(const LAS bf16x8*)(L + PK_KB + (16 * sb + fr) * 272 + (32 * ks + 8 * fq) * 2); acc = MFMA16(a, bb, acc); }
        const int s = 16 * sb + fr; const float gs = GC[s];
#pragma unroll
        for (int r = 0; r < 4; ++r) { const int c = 16 * mb + 4 * fq + r; const float v = (c > s) ? acc[r] * BE[c] * __expf(fminf(GC[c] - gs, 0.f)) : 0.f; ((LAS float*)(L + PK_AF))[c * 68 + s] = v; } }
#endif
    LDS_WAIT(); __syncthreads();
#ifndef SK_C
    if (w < 4) { const int cc = fr; float t[16];
#pragma unroll
        for (int j = 0; j < 16; ++j) t[j] = (j == cc) ? 1.f : 0.f;
#pragma unroll
        for (int r = 1; r < 16; ++r) { const LAS f32x4* arow = (const LAS f32x4*)((const LAS float*)(L + PK_AF) + (16 * w + r) * 68 + 16 * w); float a = t[r];
            f32x4 av[4];
#pragma unroll
            for (int j4 = 0; j4 < 4; ++j4) if (4 * j4 < r) av[j4] = arow[j4];
#pragma unroll
            for (int j = 0; j < r; ++j) a -= av[j >> 2][j & 3] * t[j];
            t[r] = a; asm volatile("" ::: "memory"); }
        if (lane < 16) {
#pragma unroll
            for (int r = 0; r < 16; ++r) *(LAS unsigned short*)(L + PK_TD + (16 * w + r) * 48 + cc * 2) = (unsigned short)(pk2(r == cc ? 0.f : t[r], 0.f) & 0xffffu); }
    } else { const int mb = w - 4; const int c = 16 * mb + fr; const float gcc = GC[c];
#pragma unroll 1
        for (int sb = 0; sb < 4; ++sb) { v2u o; o.x = 0u; o.y = 0u;
            if (sb <= mb) { f32x4 acc = (f32x4){0.f, 0.f, 0.f, 0.f};
#pragma unroll
                for (int ks = 0; ks < 4; ++ks) { const bf16x8 kf = *(const LAS bf16x8*)(L + PK_KB + (16 * sb + fr) * 272 + (32 * ks + 8 * fq) * 2); const bf16x8 qf = *(const LAS bf16x8*)(L + PK_QB + (16 * mb + fr) * 272 + (32 * ks + 8 * fq) * 2); acc = MFMA16(kf, qf, acc); }
                f32x4 v;
#pragma unroll
                for (int r = 0; r < 4; ++r) { const int s = 16 * sb + 4 * fq + r; v[r] = (c >= s) ? acc[r] * __expf(fminf(gcc - GC[s], 0.f)) : 0.f; }
                o = pk4(v); }
            *(GAS v2u*)(slot + SL_QK + (c * 64 + 16 * sb + 4 * fq) * 2) = o; } }
#endif
    LDS_WAIT(); __syncthreads();
#ifndef SK_D
    {
        const LAS float* AF = (const LAS float*)(L + PK_AF);
        const v2u z2 = (v2u){0u, 0u};
        bf16x8 td[4];
#pragma unroll
        for (int bb = 0; bb < 4; ++bb) td[bb] = mk8(*(const LAS v2u*)(L + PK_TD + (16 * bb + fr) * 48 + 4 * fq * 2), z2);
        const bf16x8 a10 = mk8(pk4n(*(const LAS f32x4*)(AF + (16 + fr) * 68 + 4 * fq)), z2);
        const bf16x8 a2x = mk8(pk4n(*(const LAS f32x4*)(AF + (32 + fr) * 68 + 4 * fq)), pk4n(*(const LAS f32x4*)(AF + (32 + fr) * 68 + 16 + 4 * fq)));
        const bf16x8 a3a = mk8(pk4n(*(const LAS f32x4*)(AF + (48 + fr) * 68 + 4 * fq)), pk4n(*(const LAS f32x4*)(AF + (48 + fr) * 68 + 16 + 4 * fq)));
        const bf16x8 a3b = mk8(pk4n(*(const LAS f32x4*)(AF + (48 + fr) * 68 + 32 + 4 * fq)), z2);
#pragma unroll
        for (int f = 0; f < 2; ++f) { const int n0 = 32 * w + 16 * f; const bool isU = n0 < 128; const int col = (n0 & 127) + fr;
            const LAS float* img = (const LAS float*)(L + (isU ? PK_VT : PK_KT) + col * 272);
            f32x4 X0 = *(const LAS f32x4*)(img + 4 * fq), X1 = *(const LAS f32x4*)(img + 16 + 4 * fq), X2 = *(const LAS f32x4*)(img + 32 + 4 * fq), X3 = *(const LAS f32x4*)(img + 48 + 4 * fq);
            X0 = MFMA16(td[0], mk8(pk4(X0), z2), X0);
            X1 = MFMA16(a10, mk8(pk4(X0), z2), X1); X1 = MFMA16(td[1], mk8(pk4(X1), z2), X1);
            const bf16x8 x01 = mk8(pk4(X0), pk4(X1));
            X2 = MFMA16(a2x, x01, X2); X2 = MFMA16(td[2], mk8(pk4(X2), z2), X2);
            X3 = MFMA16(a3a, x01, X3); X3 = MFMA16(a3b, mk8(pk4(X2), z2), X3); X3 = MFMA16(td[3], mk8(pk4(X3), z2), X3);
            if (isU) { unsigned char* up = slot + SL_UT + (col * 64 + 4 * fq) * 2;
                *(GAS v2u*)(up) = pk4(X0); *(GAS v2u*)(up + 32) = pk4(X1); *(GAS v2u*)(up + 64) = pk4(X2); *(GAS v2u*)(up + 96) = pk4(X3); }
            else { LAS unsigned char* wp = L + PK_QB + (4 * fq) * 272 + col * 2;
#pragma unroll
                for (int r = 0; r < 4; ++r) { *(LAS unsigned short*)(wp + (r) * 272) = (unsigned short)(pk2(-X0[r], 0.f) & 0xffffu); *(LAS unsigned short*)(wp + (16 + r) * 272) = (unsigned short)(pk2(-X1[r], 0.f) & 0xffffu);
                    *(LAS unsigned short*)(wp + (32 + r) * 272) = (unsigned short)(pk2(-X2[r], 0.f) & 0xffffu); *(LAS unsigned short*)(wp + (48 + r) * 272) = (unsigned short)(pk2(-X3[r], 0.f) & 0xffffu); } }
        }
    }
#endif
    LDS_WAIT(); __syncthreads();
#pragma unroll
    for (int i = 0; i < 2; ++i) { const int idx = tid + 512 * i, row = idx >> 4, c16 = idx & 15; *(GAS v4u*)(slot + SL_WN + row * 256 + c16 * 16) = *(const LAS v4u*)(L + PK_QB + row * 272 + c16 * 16); }
    LDS_WAIT(); __syncthreads();
}

template <bool INLINE_PREP>
__device__ __forceinline__ void delta_scan(Frame& F, int l, int bh) {
    const int b = bh >> 2, h = bh & 3; LAS unsigned char* L = F.lds; const int w = F.wave;
    bf16* ocat = (bf16*)(F.A->ws + WS_OCAT); const float* ong = F.A->in[6] + l * 128;
    f32x4 S[8];
#pragma unroll
    for (int f = 0; f < 8; ++f) S[f] = (f32x4){0.f, 0.f, 0.f, 0.f};
    for (int n = 0; n < NCH; ++n) {
        unsigned char* slot = F.A->ws + WS_RING + (size_t)(bh * NCH + n) * SLOT_BYTES;
        int lane_ = F.lane; asm volatile("" : "+v"(lane_)); const int lane = lane_, tid = w * 64 + lane, fr = lane & 15, fq = lane >> 4;
        if (INLINE_PREP) {
            GAS f32x4* sv = (GAS f32x4*)(F.A->ws + WS_SSAVE + ((size_t)bh * 512 + tid) * 128);
#pragma unroll
            for (int f = 0; f < 8; ++f) sv[f] = S[f];
            asm volatile("" ::: "memory");
            delta_prep_item(F, l, b, h, n, slot); VM_WAIT(); __syncthreads();
#pragma unroll
            for (int f = 0; f < 8; ++f) S[f] = sv[f];
        }
#pragma unroll
        for (int i = 0; i < 2; ++i) { const int idx = tid + 512 * i, row = idx >> 4, c16 = idx & 15;
            *(LAS v4u*)(L + SC_W + row * 272 + c16 * 16) = *(const GAS v4u*)(slot + SL_WN + row * 256 + c16 * 16);
            *(LAS v4u*)(L + SC_Q + row * 272 + c16 * 16) = *(const GAS v4u*)(slot + SL_QG + row * 256 + c16 * 16); }
#pragma unroll
        for (int i = 0; i < 2; ++i) { const int idx = tid + 512 * i, row = idx >> 3, c16 = idx & 7; *(LAS v4u*)(L + SC_K + row * 144 + c16 * 16) = *(const GAS v4u*)(slot + SL_KGT + row * 128 + c16 * 16); }
        { const int row = tid >> 3, c16 = tid & 7; *(LAS v4u*)(L + SC_QK + row * 144 + c16 * 16) = *(const GAS v4u*)(slot + SL_QK + row * 128 + c16 * 16); }
        const float dl = *(const GAS float*)(slot + SL_MISC);
        f32x4 vn[4], o[4];
#pragma unroll
        for (int m = 0; m < 4; ++m) { const v2u u = *(const GAS v2u*)(slot + SL_UT + ((16 * w + fr) * 64 + 16 * m + 4 * fq) * 2); vn[m] = (f32x4){bf_lo(u.x), bf_hi(u.x), bf_lo(u.y), bf_hi(u.y)}; o[m] = (f32x4){0.f, 0.f, 0.f, 0.f}; }
        LDS_WAIT(); __syncthreads();
        bf16x8 Sb[4];
#pragma unroll
        for (int ks = 0; ks < 4; ++ks) Sb[ks] = mk8(pk4(S[2 * ks]), pk4(S[2 * ks + 1]));
#pragma unroll
        for (int m = 0; m < 4; ++m)
#pragma unroll
            for (int ks = 0; ks < 4; ++ks) { const LAS unsigned char* p = L + (16 * m + fr) * 272 + (32 * ks + 4 * fq) * 2;
                vn[m] = MFMA16(mk8(*(const LAS v2u*)(p + SC_W), *(const LAS v2u*)(p + SC_W + 32)), Sb[ks], vn[m]);
                o[m] = MFMA16(mk8(*(const LAS v2u*)(p + SC_Q), *(const LAS v2u*)(p + SC_Q + 32)), Sb[ks], o[m]); }
        bf16x8 Vb[2];
#pragma unroll
        for (int kc = 0; kc < 2; ++kc) Vb[kc] = mk8(pk4(vn[2 * kc]), pk4(vn[2 * kc + 1]));
#pragma unroll
        for (int m = 0; m < 4; ++m)
#pragma unroll
            for (int kc = 0; kc < 2; ++kc) { const LAS unsigned char* p = L + SC_QK + (16 * m + fr) * 144 + (32 * kc + 4 * fq) * 2; o[m] = MFMA16(mk8(*(const LAS v2u*)p, *(const LAS v2u*)(p + 32)), Vb[kc], o[m]); }
#pragma unroll
        for (int f = 0; f < 8; ++f) { S[f] = S[f] * dl;
#pragma unroll
            for (int kc = 0; kc < 2; ++kc) { const LAS unsigned char* p = L + SC_K + (16 * f + fr) * 144 + (32 * kc + 4 * fq) * 2; S[f] = MFMA16(mk8(*(const LAS v2u*)p, *(const LAS v2u*)(p + 32)), Vb[kc], S[f]); } }
#pragma unroll
        for (int m = 0; m < 4; ++m)
#pragma unroll
            for (int r = 0; r < 4; ++r) ((LAS float*)(L + SC_O))[(16 * m + 4 * fq + r) * 132 + 16 * w + fr] = o[m][r];
        LDS_WAIT(); __syncthreads();
        {
            const int row = tid >> 3, seg = tid & 7; const LAS float* orow = (const LAS float*)(L + SC_O) + row * 132 + 16 * seg;
            f32x4 v[4]; float s = 0.f;
#pragma unroll
            for (int j = 0; j < 4; ++j) { v[j] = *(const LAS f32x4*)(orow + 4 * j); s += (v[j].x * v[j].x + v[j].y * v[j].y) + (v[j].z * v[j].z + v[j].w * v[j].w); }
            s += __shfl_xor(s, 1); s += __shfl_xor(s, 2); s += __shfl_xor(s, 4);
            const float rs = 1.0f / sqrtf(s * (1.0f / 128.0f) + 1e-6f);
            bf16* zp = ocat + (size_t)(b * T + n * CH + row) * D + h * 128 + 16 * seg;
            const v4u z0 = *(const GAS v4u*)zp, z1 = *(const GAS v4u*)(zp + 8);
            const unsigned zz[8] = {z0.x, z0.y, z0.z, z0.w, z1.x, z1.y, z1.z, z1.w}; unsigned oo[8];
#pragma unroll
            for (int j = 0; j < 8; ++j) { const int e = 16 * seg + 2 * j; const float a = v[j >> 1][(2 * j) & 3] * rs * ong[e] * bf_lo(zz[j]); const float c = v[j >> 1][(2 * j + 1) & 3] * rs * ong[e + 1] * bf_hi(zz[j]); oo[j] = pk2(a, c); }
            *(GAS v4u*)zp = (v4u){oo[0], oo[1], oo[2], oo[3]}; *(GAS v4u*)(zp + 8) = (v4u){oo[4], oo[5], oo[6], oo[7]};
        }
        __syncthreads();
    }
}

__device__ __forceinline__ void gmlp_item(Frame& F, int l, int item) {
    const int g = item & 3, n = (item >> 2) & 15, b = item >> 6; const int R0 = b * T + n * GMC;
    const bf16* vg = (const bf16*)(F.A->ws + WS_VG); bf16* ocat = (bf16*)(F.A->ws + WS_OCAT); const bf16* wsb = layer_w(F.A->ws, l).wsb + (size_t)g * 128 * 128;
    const float* lng = F.A->in[7] + l * 512 + g * 128; const float* lnb = F.A->in[8] + l * 512 + g * 128; const float* bs = F.A->in[10] + (size_t)l * 512 + g * 128;
    LAS unsigned char* L = F.lds; int lane_ = F.lane; asm volatile("" : "+v"(lane_)); const int lane = lane_, w = F.wave, fr = lane & 15, fq = lane >> 4;
    { const int ch = 2 * lane; const float g0 = lng[ch], g1 = lng[ch + 1], b0 = lnb[ch], b1 = lnb[ch + 1]; float y0[16], y1[16];
#pragma unroll
      for (int i = 0; i < 16; ++i) { const unsigned u = *(const GAS unsigned*)(vg + (size_t)(R0 + 16 * w + i) * 512 + g * 128 + ch); const float a0 = bf_lo(u), a1 = bf_hi(u);
          const float mu = wave_sum(a0 + a1) * (1.0f / 128.0f); const float d0 = a0 - mu, d1 = a1 - mu; const float var = wave_sum(d0 * d0 + d1 * d1) * (1.0f / 128.0f); const float rs = 1.0f / sqrtf(var + 1e-6f);
          y0[i] = d0 * rs * g0 + b0; y1[i] = d1 * rs * g1 + b1; }
      *(LAS v4u*)(L + ch * 272 + 32 * w) = (v4u){pk2(y0[0], y0[1]), pk2(y0[2], y0[3]), pk2(y0[4], y0[5]), pk2(y0[6], y0[7])};
      *(LAS v4u*)(L + ch * 272 + 32 * w + 16) = (v4u){pk2(y0[8], y0[9]), pk2(y0[10], y0[11]), pk2(y0[12], y0[13]), pk2(y0[14], y0[15])};
      *(LAS v4u*)(L + (ch + 1) * 272 + 32 * w) = (v4u){pk2(y1[0], y1[1]), pk2(y1[2], y1[3]), pk2(y1[4], y1[5]), pk2(y1[6], y1[7])};
      *(LAS v4u*)(L + (ch + 1) * 272 + 32 * w + 16) = (v4u){pk2(y1[8], y1[9]), pk2(y1[10], y1[11]), pk2(y1[12], y1[13]), pk2(y1[14], y1[15])}; }
    LDS_WAIT(); __syncthreads();
    const int t = 16 * w + fr; const int nks = (16 * w + 15) / 32 + 1;
    bf16x8 wf[4];
#pragma unroll
    for (int ks = 0; ks < 4; ++ks) wf[ks] = (ks < nks) ? *(const GAS bf16x8*)(wsb + (size_t)t * 128 + 32 * ks + 8 * fq) : (bf16x8){0, 0, 0, 0, 0, 0, 0, 0};
    const float bst = bs[t];
#pragma unroll
    for (int nf = 0; nf < 8; ++nf) { f32x4 acc = (f32x4){0.f, 0.f, 0.f, 0.f};
#pragma unroll
        for (int ks = 0; ks < 4; ++ks) if (ks < nks) { const bf16x8 vf = *(const LAS bf16x8*)(L + (16 * nf + fr) * 272 + (32 * ks + 8 * fq) * 2); acc = MFMA16(vf, wf[ks], acc); }
        bf16* up = ocat + (size_t)(R0 + t) * D + 512 + g * 128 + 16 * nf + 4 * fq; const v2u u = *(const GAS v2u*)up;
        v2u o; o.x = pk2(bf_lo(u.x) * (acc[0] + bst), bf_hi(u.x) * (acc[1] + bst)); o.y = pk2(bf_lo(u.y) * (acc[2] + bst), bf_hi(u.y) * (acc[3] + bst));
        *(GAS v2u*)up = o; }
    __syncthreads();
}

__device__ __forceinline__ void final_norm(Frame& F) {
    const int gw = F.vcu * NWAVES + F.wave, NGW = F.G * NWAVES; const float* ssq = (const float*)(F.A->ws + WS_SSQ); const float* gn = F.A->in[16];
    f32x4 gv[4];
#pragma unroll
    for (int j = 0; j < 4; ++j) gv[j] = *(const GAS f32x4*)(gn + 4 * F.lane + 256 * j);
    for (int m = gw; m < M; m += NGW) { const float rs = pg8::row_rs(ssq, m); GAS f32x4* xr = (GAS f32x4*)(F.A->out + (size_t)m * D) + F.lane;
#pragma unroll
        for (int j = 0; j < 4; ++j) { f32x4 v = xr[64 * j]; v = v * rs * gv[j]; xr[64 * j] = v; } }
}

__global__ void __launch_bounds__(NWAVES * 64, 2) hyb_fwd(Args args) {
    extern __shared__ __attribute__((aligned(16))) unsigned char lds[];
    Frame F;
    F.lds = (LAS unsigned char*)lds;
    F.tid = threadIdx.x; F.lane = F.tid & 63; F.wave = __builtin_amdgcn_readfirstlane(F.tid >> 6);
    const int wave0 = F.wave;
    F.G = gridDim.x; { const int bx = blockIdx.x; F.vcu = (F.G % 8 == 0) ? (bx % 8) * (F.G / 8) + bx / 8 : bx; }
    F.A = (const CAS Args*)__builtin_amdgcn_kernarg_segment_ptr();
    gu32* ctl = (gu32*)(args.ws + WS_CTL);
    volatile LAS unsigned* MISC = (volatile LAS unsigned*)(F.lds + MISC_OFF);
    for (int u = F.tid; u < (LDS_BYTES - RING_BYTES) / 4; u += NWAVES * 64) ((LAS unsigned*)(F.lds + RING_BYTES))[u] = 0u;
    __syncthreads();
    const int lo = args.ph_lo, hi = args.ph_hi;
    const bool multi = (hi - lo) > 1;
    XcdBarrier bar; bar.bar = (unsigned*)(ctl + CW_BAR); bar.x = 0; bar.st = nullptr;
    if (multi) bar = xcd_barrier_post((unsigned*)(ctl + CW_BAR), MISC + 8);
#define RELAUNDER() do { int t_ = wave0 * 64 + (int)__builtin_amdgcn_mbcnt_hi(~0u, __builtin_amdgcn_mbcnt_lo(~0u, 0u)); asm volatile("" : "+v"(t_)); F.tid = t_; F.lane = t_ & 63; F.wave = wave0; const CAS Args* a_ = (const CAS Args*)__builtin_amdgcn_kernarg_segment_ptr(); asm volatile("" : "+s"(a_)); F.A = a_; } while (0)
#define IN(k) (lo <= (k) && (k) < hi)
#define SEAM(k) do { if (IN(k) && IN((k) + 1)) xcd_barrier(bar, wave0); } while (0)
#define WSP(off) (F.A->ws + (off))
#ifndef NO_P0
    if (IN(0)) { RELAUNDER(); p0_prologue(F); }
#endif
    SEAM(0);
#pragma unroll 1
    for (int l = 0; l < DEPTH; ++l) { const int pb = 1 + 5 * l;
        if (IN(pb)) {
            RELAUNDER();
#ifndef NO_G1
            { pg8::Gemm g{(bf16*)WSP(WS_HB), layer_w(F.A->ws, l).win, M, NPROJ, D}; pg8::StaticOrder S; S.init(M, NPROJ, F.G, (int)blockIdx.x);
              pg8::EpiProj E{(bf16*)WSP(WS_QKV), (bf16*)WSP(WS_OCAT), (bf16*)WSP(WS_VG), (const float*)WSP(WS_SSQ)};
              pg8::gemm_phase<pg8::EpiProj, pg8::StaticOrder, true, true>(F.lds, g, S, E, wave0); }
#endif
#ifndef NO_BA
            RELAUNDER();
            for (int r0 = 64 * (int)blockIdx.x; r0 < M; r0 += 64 * F.G) ba_rows(F, l, r0);
#endif
        } SEAM(pb);
        if (IN(pb + 1)) {
            RELAUNDER();
            if ((int)blockIdx.x < 32) {
#ifndef NO_DELTA
#if defined(T_SCAN_ONLY)
                delta_scan<false>(F, l, (int)blockIdx.x);
#elif defined(T_PREP_ONLY)
                for (int n = 0; n < NCH; ++n) delta_prep_item(F, l, (int)blockIdx.x >> 2, (int)blockIdx.x & 3, n, F.A->ws + WS_RING + (size_t)((int)blockIdx.x * NCH + n) * SLOT_BYTES);
#else
                delta_scan<true>(F, l, (int)blockIdx.x);
#endif
#endif
            } else {
#ifndef NO_GMLP
                for (int it = (int)blockIdx.x - 32; it < 512; it += F.G - 32) gmlp_item(F, l, it);
#endif
            }
        } SEAM(pb + 1);
        if (IN(pb + 2)) {
            RELAUNDER();
#ifndef NO_G2
            pg8::Gemm g{(bf16*)WSP(WS_OCAT), layer_w(F.A->ws, l).wout, M, D, D}; pg8::StaticOrder S; S.init(M, D, F.G, (int)blockIdx.x);
            pg8::EpiRes E{l == 0 ? F.A->in[0] : F.A->out, F.A->out, (bf16*)WSP(WS_HB), (float*)WSP(WS_SSQ)};
            pg8::gemm_phase<pg8::EpiRes, pg8::StaticOrder, false, true>(F.lds, g, S, E, wave0);
#endif
        } SEAM(pb + 2);
        if (IN(pb + 3)) {
            RELAUNDER();
#ifndef NO_G3
            pg8::Gemm g{(bf16*)WSP(WS_HB), layer_w(F.A->ws, l).wgu, M, NGU, D}; pg8::StaticOrder S; S.init(M, NGU, F.G, (int)blockIdx.x);
            pg8::EpiSwiglu E{(bf16*)WSP(WS_HID), (const float*)WSP(WS_SSQ)};
            pg8::gemm_phase<pg8::EpiSwiglu, pg8::StaticOrder, true, true>(F.lds, g, S, E, wave0);
#endif
        } SEAM(pb + 3);
        if (IN(pb + 4)) {
            RELAUNDER();
#ifndef NO_G4
            pg8::Gemm g{(bf16*)WSP(WS_HID), layer_w(F.A->ws, l).wdn, M, D, DFF}; pg8::StaticOrder S; S.init(M, D, F.G, (int)blockIdx.x);
            pg8::EpiRes E{F.A->out, F.A->out, (bf16*)WSP(WS_HB), (float*)WSP(WS_SSQ)};
            pg8::gemm_phase<pg8::EpiRes, pg8::StaticOrder, false, true>(F.lds, g, S, E, wave0);
#endif
        } SEAM(pb + 4);
    }
#ifndef NO_FN
    if (IN(11)) { RELAUNDER(); final_norm(F); }
#endif
#undef IN
#undef SEAM
}

extern "C" void kernel_launch(void* const* d_in, const int* in_sizes, int n_in, void* d_out, int out_size, void* d_ws, size_t ws_size, hipStream_t stream) {
    static int grid = 0;
    if (grid == 0) {
        if (n_in != 17 || in_sizes[0] != M * D || out_size != M * D || ws_size < WS_END) { fprintf(stderr, "kernel_launch: unexpected shapes (n_in %d, in0 %d, out %d, ws %zu < %zu)\n", n_in, n_in > 0 ? in_sizes[0] : -1, out_size, ws_size, (size_t)WS_END); grid = -1; return; }
        int dev = 0, cus = 0, per_cu = 0;
        if (hipGetDevice(&dev) != hipSuccess || hipDeviceGetAttribute(&cus, hipDeviceAttributeMultiprocessorCount, dev) != hipSuccess) { grid = -1; return; }
        if (hipFuncSetAttribute((const void*)hyb_fwd, hipFuncAttributeMaxDynamicSharedMemorySize, LDS_BYTES) != hipSuccess) { fprintf(stderr, "kernel_launch: hipFuncSetAttribute failed\n"); grid = -1; return; }
        if (hipOccupancyMaxActiveBlocksPerMultiprocessor(&per_cu, (const void*)hyb_fwd, NWAVES * 64, LDS_BYTES) != hipSuccess || per_cu < 1) { fprintf(stderr, "kernel_launch: occupancy query says %d blocks per CU\n", per_cu); per_cu = 1; }
        (void)hipGetLastError();
        grid = cus;
    }
    if (grid < 0) return;
    (void)hipMemsetAsync((char*)d_ws + WS_CTL, 0, CTL_BYTES, stream);
    Args a{};
    for (int i = 0; i < 17; ++i) a.in[i] = (const float*)d_in[i];
    a.out = (float*)d_out; a.ws = (unsigned char*)d_ws;
    if (MK_N_LAUNCHES == 1) {
        a.ph_lo = 0; a.ph_hi = N_PHASES;
        void* params[] = {&a};
        hipError_t e = hipLaunchCooperativeKernel((const void*)hyb_fwd, dim3(grid), dim3(NWAVES * 64), params, LDS_BYTES, stream);
        if (e != hipSuccess) fprintf(stderr, "kernel_launch: cooperative launch failed: %s (grid %d)\n", hipGetErrorString(e), grid);
    } else {
        for (int p = 0; p < N_PHASES; ++p) { a.ph_lo = p; a.ph_hi = p + 1; hipLaunchKernelGGL(hyb_fwd, dim3(grid), dim3(NWAVES * 64), LDS_BYTES, stream, a); }
    }
}
```

```cpp
#include <hip/hip_runtime.h>
#include <cstdio>
#include <cstdint>
namespace pg8 {
#define PG8_LAS __attribute__((address_space(3)))
typedef unsigned short bf16_t;
typedef short bf16x8 __attribute__((ext_vector_type(8)));
typedef float f32x4 __attribute__((ext_vector_type(4)));
typedef unsigned u32x4 __attribute__((ext_vector_type(4)));
constexpr int BM = 256, BK = 64, HALF = 128, HTB = HALF * BK * 2  , STAGE_BYTES = 8 * HTB, NXCD = 8, WGM = 8;

__host__ __device__ __forceinline__ int lds_byte(int r, int c) { const int st = (r >> 4) * 2 + (c >> 5), rr = r & 15, cc = c & 31, ob = rr * 64 + cc * 2; return st * 1024 + (ob ^ (((ob >> 9) & 1) << 5)); }
__host__ __device__ __forceinline__ void stage_rc(int b, int& R, int& C) { const int st = b / 1024, sb = b % 1024, swz = sb ^ (((sb >> 9) & 1) << 5); R = (st >> 1) * 16 + swz / 64; C = (st & 1) * 32 + (swz % 64) / 2; }
__host__ __device__ __forceinline__ int perm32(int rho) { const int n = rho >> 4, i = rho & 15; return 8 * (i >> 2) + 4 * n + (i & 3); }

struct Unit { int pm, pn; };
struct Gemm { const bf16_t* A; const bf16_t* Bt; int M, N, K; };

struct StaticOrder {
    int nM, nN, nwg, G, c;
    __host__ __device__ void init(int M, int N, int G_, int c_) { nM = M / BM; nN = N / BM; nwg = nM * nN; G = G_; c = c_; }
    __host__ __device__ bool next(int i, Unit& u) const {
        const long L = (long)i * G + c; if (L >= nwg) return false;
        int wgid = (int)L; { const int q = nwg / NXCD, r = nwg % NXCD, xcd = wgid % NXCD, off = wgid / NXCD; wgid = (xcd < r ? xcd * (q + 1) : r * (q + 1) + (xcd - r) * q) + off; }
        const int nig = WGM * nN, gid = wgid / nig, fm = gid * WGM, gsz = (nM - fm) < WGM ? (nM - fm) : WGM;
        u.pm = fm + ((wgid % nig) % gsz); u.pn = (wgid % nig) / gsz; return true;
    }
    __device__ __forceinline__ void a_ready(const Unit&) const {}
    __device__ __forceinline__ void done(const Unit&) const {}
};

typedef float f32x2_t __attribute__((ext_vector_type(2))); typedef __bf16 bf16x2_t __attribute__((ext_vector_type(2)));
__device__ __forceinline__ unsigned cvt_pk_bf16(float lo, float hi) { f32x2_t v = {lo, hi}; bf16x2_t b = __builtin_convertvector(v, bf16x2_t); return __builtin_bit_cast(unsigned, b); }
typedef float f32x2 __attribute__((ext_vector_type(2)));
typedef unsigned u32x2 __attribute__((ext_vector_type(2)));
constexpr float RMS_EPS = 1e-6f;
__device__ __forceinline__ float fast_sigmoid(float x) { return __builtin_amdgcn_rcpf(1.0f + __builtin_amdgcn_exp2f(-1.4426950408889634f * x)); }
__device__ __forceinline__ float silu_f(float x) { return x * fast_sigmoid(x); }
__device__ __forceinline__ float gelu_tanh_f(float x) { const float z = 1.5957691216057308f * (x + 0.044715f * x * x * x); return x * fast_sigmoid(z); }
__device__ __forceinline__ float row_rs(const float* ssq, int row) { const f32x4 s = *(const f32x4*)(ssq + (size_t)row * 4); return 1.0f / sqrtf(((s[0] + s[1]) + (s[2] + s[3])) * (1.0f / 1024.0f) + RMS_EPS); }

struct EpiProj {
    static constexpr bool PERM = true, AFTER_DRAIN = false;
    bf16_t* qkv; bf16_t* ocat; bf16_t* vg; const float* ssq;
    __device__ __forceinline__ void operator()(const f32x4 (&acc)[2][2][4][2], const Unit& u, int wr, int wc, int fr, int fq) const {
        const int pn = u.pn; bf16_t* base; int ldc, colt, act;
        if (pn < 6) { base = qkv; ldc = 1536; colt = 256 * pn; act = 0; }
        else if (pn < 8) { base = ocat; ldc = 1024; colt = 256 * (pn - 6); act = 1; }
        else if (pn < 10) { base = ocat; ldc = 1024; colt = 512 + 256 * (pn - 8); act = 2; }
        else { base = vg; ldc = 512; colt = 256 * (pn - 10); act = 2; }
        const int row0 = u.pm * BM + wr * 64 + fr, col0 = colt + wc * 32 + 8 * fq;
#pragma unroll
        for (int ai = 0; ai < 2; ++ai)
#pragma unroll
            for (int m = 0; m < 4; ++m) { const int r = row0 + ai * HALF + m * 16; const float rs = row_rs(ssq, r); bf16_t* rowp = base + (size_t)r * ldc + col0;
#pragma unroll
                for (int bj = 0; bj < 2; ++bj) { f32x4 v0 = acc[ai][bj][m][0] * rs, v1 = acc[ai][bj][m][1] * rs;
                    if (act == 1) {
#pragma unroll
                        for (int e = 0; e < 4; ++e) { v0[e] = silu_f(v0[e]); v1[e] = silu_f(v1[e]); } }
                    else if (act == 2) {
#pragma unroll
                        for (int e = 0; e < 4; ++e) { v0[e] = gelu_tanh_f(v0[e]); v1[e] = gelu_tanh_f(v1[e]); } }
                    u32x4 w; w.x = cvt_pk_bf16(v0[0], v0[1]); w.y = cvt_pk_bf16(v0[2], v0[3]); w.z = cvt_pk_bf16(v1[0], v1[1]); w.w = cvt_pk_bf16(v1[2], v1[3]);
                    *(u32x4*)(rowp + bj * HALF) = w; } }
    }
};

struct EpiSwiglu {
    static constexpr bool PERM = true, AFTER_DRAIN = false;
    bf16_t* hid; const float* ssq;
    __device__ __forceinline__ void operator()(const f32x4 (&acc)[2][2][4][2], const Unit& u, int wr, int wc, int fr, int fq) const {
        const int row0 = u.pm * BM + wr * 64 + fr, col0 = u.pn * HALF + wc * 32 + 8 * fq;
#pragma unroll
        for (int ai = 0; ai < 2; ++ai)
#pragma unroll
            for (int m = 0; m < 4; ++m) { const int r = row0 + ai * HALF + m * 16; const float rs = row_rs(ssq, r);
                f32x4 g0 = acc[ai][0][m][0] * rs, g1 = acc[ai][0][m][1] * rs, u0 = acc[ai][1][m][0] * rs, u1 = acc[ai][1][m][1] * rs;
#pragma unroll
                for (int e = 0; e < 4; ++e) { g0[e] = silu_f(g0[e]) * u0[e]; g1[e] = silu_f(g1[e]) * u1[e]; }
                u32x4 w; w.x = cvt_pk_bf16(g0[0], g0[1]); w.y = cvt_pk_bf16(g0[2], g0[3]); w.z = cvt_pk_bf16(g1[0], g1[1]); w.w = cvt_pk_bf16(g1[2], g1[3]);
                *(u32x4*)(hid + (size_t)r * 2816 + col0) = w; }
    }
};

struct EpiRes {
    static constexpr bool PERM = false, AFTER_DRAIN = true;
    const float* base; float* out; bf16_t* hb; float* ssq;
    __device__ __forceinline__ void fused(f32x4 (&acc)[2][2][4][2], const Unit& u, int wr, int wc, int fr, int fq, PG8_LAS unsigned char* lds, int wid, int lane) const {
        PG8_LAS float* P = (PG8_LAS float*)lds;
        const int col0 = u.pn * BM + wc * 32 + 4 * fq;
#pragma unroll
        for (int ai = 0; ai < 2; ++ai)
#pragma unroll
            for (int m = 0; m < 4; ++m) { const int rl = ai * HALF + wr * 64 + m * 16 + fr; const size_t off = (size_t)(u.pm * BM + rl) * 1024 + col0; float s = 0.f;
#pragma unroll
                for (int bj = 0; bj < 2; ++bj)
#pragma unroll
                    for (int n = 0; n < 2; ++n) { const f32x4 b = *(const f32x4*)(base + off + bj * HALF + n * 16); const f32x4 o = b + acc[ai][bj][m][n];
                        *(f32x4*)(out + off + bj * HALF + n * 16) = o; u32x2 w; w.x = cvt_pk_bf16(o[0], o[1]); w.y = cvt_pk_bf16(o[2], o[3]);
                        *(u32x2*)(hb + off + bj * HALF + n * 16) = w; s += (o[0] * o[0] + o[1] * o[1]) + (o[2] * o[2] + o[3] * o[3]); }
                s += __shfl_xor(s, 16); s += __shfl_xor(s, 32);
                if (fq == 0) P[rl * 4 + wc] = s;
                if (m & 1) asm volatile("" ::: "memory"); }
        asm volatile("s_waitcnt lgkmcnt(0)" ::: "memory"); __builtin_amdgcn_s_barrier(); asm volatile("" ::: "memory");
        const int tid = wid * 64 + lane;
        if (tid < 256) { const float t = (P[tid * 4 + 0] + P[tid * 4 + 1]) + (P[tid * 4 + 2] + P[tid * 4 + 3]); ssq[(size_t)(u.pm * BM + tid) * 4 + u.pn] = t; }
        asm volatile("s_waitcnt lgkmcnt(0)" ::: "memory"); __builtin_amdgcn_s_barrier(); asm volatile("" ::: "memory");
    }
};

template <class Epi, class Sched, bool ALIGN_EPI = false, bool SP2 = false>
__device__ __forceinline__ void gemm_phase(PG8_LAS unsigned char* lds, const Gemm g, const Sched& S, const Epi& E, const int wave_id  ) {
    int tid_ = wave_id * 64 + (int)__builtin_amdgcn_mbcnt_hi(~0u, __builtin_amdgcn_mbcnt_lo(~0u, 0u)); asm volatile("" : "+v"(tid_));
    const int tid = tid_, wid = __builtin_amdgcn_readfirstlane(tid >> 6), lane = tid & 63, wr = wid >> 2, wc = wid & 3, fr = lane & 15, fq = lane >> 4;
    const int K = g.K, nt = K / BK;
    unsigned voffA[2], voffB[2];
#pragma unroll
    for (int i = 0; i < 2; ++i) { int R, C; stage_rc(tid * 16 + i * 8192, R, C); const int Rb = Epi::PERM ? ((R & ~31) + perm32(R & 31)) : R;
        voffA[i] = (unsigned)(R * K + C) * 2u; voffB[i] = (unsigned)(Rb * K + C) * 2u; }
    const size_t kstep = (size_t)(BK * 2);
    const size_t hstep = (size_t)HALF * K * 2;
    const size_t tstep = 2 * hstep;
    const unsigned ldsw = (unsigned)wid * 1024u;
    const int aoff = lds_byte(wr * 64 + fr, fq * 8), boff = lds_byte(wc * 32 + fr, fq * 8);
#define PG8_SA(b, h) (((b) * 2 + (h)) * HTB)
#define PG8_SB(b, h) ((4 + (b) * 2 + (h)) * HTB)
#define PG8_STAGE(bufoff, gbase, voff) do { _Pragma("unroll") for (int _i = 0; _i < 2; ++_i) \
        __builtin_amdgcn_global_load_lds((const unsigned*)((const char*)(gbase) + (voff)[_i]), (PG8_LAS unsigned*)(lds + (bufoff) + ldsw + _i * 8192), 16, 0, 0); } while (0)
#define PG8_LDA(dst, b, h) do { _Pragma("unroll") for (int m = 0; m < 4; ++m) _Pragma("unroll") for (int k = 0; k < 2; ++k) dst[m][k] = *(const PG8_LAS bf16x8*)(lds + PG8_SA(b, h) + aoff + m * 2048 + k * 1024); } while (0)
#define PG8_LDB(dst, b, h) do { _Pragma("unroll") for (int n = 0; n < 2; ++n) _Pragma("unroll") for (int k = 0; k < 2; ++k) dst[n][k] = *(const PG8_LAS bf16x8*)(lds + PG8_SB(b, h) + boff + n * 2048 + k * 1024); } while (0)
#define PG8_MMA(ai, bj, At, Bt) do { __builtin_amdgcn_s_setprio(1); _Pragma("unroll") for (int m = 0; m < 4; ++m) _Pragma("unroll") for (int n = 0; n < 2; ++n) _Pragma("unroll") for (int k = 0; k < 2; ++k) \
        acc[ai][bj][m][n] = __builtin_amdgcn_mfma_f32_16x16x32_bf16(Bt[n][k], At[m][k], acc[ai][bj][m][n], 0, 0, 0); __builtin_amdgcn_s_setprio(0); } while (0)
#define PG8_WAIT_V(n) asm volatile("s_waitcnt vmcnt(" #n ")" ::: "memory")
#define PG8_WAIT_L(n) asm volatile("s_waitcnt lgkmcnt(" #n ")" ::: "memory")
#define PG8_BAR __builtin_amdgcn_s_barrier()
#define PG8_SCHED __builtin_amdgcn_sched_barrier(0)
    Unit cur, nxt; int ui = 0;
    if (!S.next(0, cur)) return;
    f32x4 acc[2][2][4][2];
#pragma unroll
    for (int a = 0; a < 2; ++a)
#pragma unroll
        for (int b = 0; b < 2; ++b)
#pragma unroll
            for (int m = 0; m < 4; ++m)
#pragma unroll
                for (int n = 0; n < 2; ++n) acc[a][b][m][n] = (f32x4){0.f, 0.f, 0.f, 0.f};
    bf16x8 At[4][2], B0[2][2], B1[2][2];
    const char* cA = (const char*)g.A + (size_t)cur.pm * tstep; const char* cB = (const char*)g.Bt + (size_t)cur.pn * tstep;
    S.a_ready(cur);
    if constexpr (SP2) {
        PG8_STAGE(PG8_SB(0, 0), cB, voffB); PG8_STAGE(PG8_SB(0, 1), cB + hstep, voffB); PG8_STAGE(PG8_SA(0, 0), cA, voffA); PG8_STAGE(PG8_SA(0, 1), cA + hstep, voffA);
        if (wr == 1) PG8_BAR;
        PG8_WAIT_V(2); PG8_BAR;
        PG8_STAGE(PG8_SB(1, 0), cB + kstep, voffB); PG8_STAGE(PG8_SA(1, 0), cA + kstep, voffA); PG8_STAGE(PG8_SB(1, 1), cB + hstep + kstep, voffB);
        PG8_WAIT_V(6); PG8_BAR;
    } else {
        PG8_STAGE(PG8_SB(0, 0), cB, voffB); PG8_STAGE(PG8_SA(0, 0), cA, voffA); PG8_STAGE(PG8_SB(0, 1), cB + hstep, voffB); PG8_STAGE(PG8_SA(0, 1), cA + hstep, voffA);
        if (wr == 1) PG8_BAR;
        PG8_WAIT_V(4); PG8_BAR;
        PG8_STAGE(PG8_SB(1, 0), cB + kstep, voffB); PG8_STAGE(PG8_SA(1, 0), cA + kstep, voffA); PG8_STAGE(PG8_SB(1, 1), cB + hstep + kstep, voffB);
        PG8_WAIT_V(6); PG8_BAR;
    }
    for (;;) {
        const bool has_next = S.next(ui + 1, nxt);
        const char* nA = has_next ? (const char*)g.A + (size_t)nxt.pm * tstep : cA; const char* nB = has_next ? (const char*)g.Bt + (size_t)nxt.pn * tstep : cB;
        for (int t = 0; t < nt; t += 2) {
            const bool last = (t == nt - 2);
            const char* a1 = cA + (size_t)(t + 1) * kstep;
            const char* a2 = last ? nA : cA + (size_t)(t + 2) * kstep; const char* b2 = last ? nB : cB + (size_t)(t + 2) * kstep;
            const char* a3 = a2 + kstep; const char* b3 = b2 + kstep;
            if (last && has_next) S.a_ready(nxt);
            if constexpr (SP2) {
            PG8_LDB(B0, 0, 0); PG8_LDB(B1, 0, 1); PG8_SCHED; PG8_LDA(At, 0, 0); PG8_STAGE(PG8_SA(1, 1), a1 + hstep, voffA);
            PG8_WAIT_V(8); PG8_WAIT_L(0); PG8_BAR; PG8_MMA(0, 0, At, B0); PG8_MMA(0, 1, At, B1); PG8_BAR; PG8_SCHED;
            PG8_LDA(At, 0, 1); PG8_STAGE(PG8_SB(0, 0), b2, voffB); PG8_STAGE(PG8_SB(0, 1), b2 + hstep, voffB); PG8_STAGE(PG8_SA(0, 0), a2, voffA);
            PG8_WAIT_V(8); PG8_WAIT_L(0); PG8_BAR; PG8_MMA(1, 0, At, B0); PG8_MMA(1, 1, At, B1); PG8_BAR; PG8_SCHED;
            PG8_LDB(B0, 1, 0); PG8_LDB(B1, 1, 1); PG8_SCHED; PG8_LDA(At, 1, 0); PG8_STAGE(PG8_SA(0, 1), a2 + hstep, voffA);
            PG8_WAIT_V(8); PG8_WAIT_L(0); PG8_BAR; PG8_MMA(0, 0, At, B0); PG8_MMA(0, 1, At, B1); PG8_BAR; PG8_SCHED;
            PG8_LDA(At, 1, 1); PG8_STAGE(PG8_SB(1, 0), b3, voffB); PG8_STAGE(PG8_SB(1, 1), b3 + hstep, voffB); PG8_STAGE(PG8_SA(1, 0), a3, voffA);
            PG8_WAIT_V(8); PG8_WAIT_L(0); PG8_BAR; PG8_MMA(1, 0, At, B0); PG8_MMA(1, 1, At, B1); PG8_BAR; PG8_SCHED;
            } else {
            PG8_LDB(B0, 0, 0); PG8_SCHED; PG8_LDA(At, 0, 0); PG8_STAGE(PG8_SA(1, 1), a1 + hstep, voffA);
            PG8_WAIT_L(8); PG8_BAR; PG8_WAIT_L(0); PG8_MMA(0, 0, At, B0); PG8_BAR; PG8_SCHED;
            PG8_LDB(B1, 0, 1); PG8_STAGE(PG8_SB(0, 0), b2, voffB);
            PG8_BAR; PG8_WAIT_L(0); PG8_MMA(0, 1, At, B1); PG8_BAR;
            PG8_LDA(At, 0, 1); PG8_STAGE(PG8_SA(0, 0), a2, voffA);
            PG8_BAR; PG8_WAIT_L(0); PG8_MMA(1, 0, At, B0); PG8_BAR; PG8_SCHED;
            PG8_STAGE(PG8_SB(0, 1), b2 + hstep, voffB);
            PG8_WAIT_V(6); PG8_BAR; PG8_MMA(1, 1, At, B1); PG8_BAR;
            PG8_LDB(B0, 1, 0); PG8_SCHED; PG8_LDA(At, 1, 0); PG8_STAGE(PG8_SA(0, 1), a2 + hstep, voffA);
            PG8_WAIT_L(8); PG8_BAR; PG8_WAIT_L(0); PG8_MMA(0, 0, At, B0); PG8_BAR; PG8_SCHED;
            PG8_LDB(B1, 1, 1); PG8_STAGE(PG8_SB(1, 0), b3, voffB);
            PG8_BAR; PG8_WAIT_L(0); PG8_MMA(0, 1, At, B1); PG8_BAR;
            PG8_LDA(At, 1, 1); PG8_STAGE(PG8_SA(1, 0), a3, voffA);
            PG8_BAR; PG8_WAIT_L(0); PG8_MMA(1, 0, At, B0); PG8_BAR; PG8_SCHED;
            PG8_STAGE(PG8_SB(1, 1), b3 + hstep, voffB);
            PG8_WAIT_V(6); PG8_BAR; PG8_MMA(1, 1, At, B1); PG8_BAR;
            }
        }
        if constexpr (ALIGN_EPI) { if (wr == 0) PG8_BAR; }
        if constexpr (!Epi::AFTER_DRAIN) { E(acc, cur, wr, wc, fr, fq); S.done(cur); }
        if (!has_next) break;
#pragma unroll
        for (int a = 0; a < 2; ++a)
#pragma unroll
            for (int b = 0; b < 2; ++b)
#pragma unroll
                for (int m = 0; m < 4; ++m)
#pragma unroll
                    for (int n = 0; n < 2; ++n) acc[a][b][m][n] = (f32x4){0.f, 0.f, 0.f, 0.f};
        cur = nxt; cA = nA; cB = nB; ++ui;
        if constexpr (ALIGN_EPI) { if (wr == 1) PG8_BAR; }
    }
    PG8_WAIT_V(0);
    if constexpr (!ALIGN_EPI) { if (wr == 0) PG8_BAR; }
    PG8_BAR;
    if constexpr (Epi::AFTER_DRAIN) { E.fused(acc, cur, wr, wc, fr, fq, lds, wid, lane); S.done(cur); }
#undef PG8_SA
#undef PG8_SB
#undef PG8_STAGE
#undef PG8_LDA
#undef PG8_LDB
#undef PG8_MMA
#undef PG8_WAIT_V
#undef PG8_WAIT_L
#undef PG8_BAR
#undef PG8_SCHED
}
}

constexpr int NWAVES = 8;
#ifndef MK_N_LAUNCHES
#define MK_N_LAUNCHES 1
#endif
constexpr int N_PHASES = 12;
constexpr int BATCH = 8, T = 2048, D = 1024, M = BATCH * T, DEPTH = 2;
constexpr int NPROJ = 3072, IN_DIM = 3080, QKV = 1536, DFF = 2816, NGU = 2 * DFF;
constexpr int NH = 4, DK = 128, CH = 64, NCH = T / CH;
constexpr int GMC = 128;
constexpr size_t WS_CTL = 0, CTL_BYTES = 1u << 20;
constexpr size_t SZ_WIN = (size_t)NPROJ * D * 2, SZ_WBA = 16 * D * 2, SZ_WOUT = (size_t)D * D * 2, SZ_WGU = (size_t)NGU * D * 2, SZ_WDN = (size_t)D * DFF * 2, SZ_WSB = 4 * 128 * 128 * 2;
constexpr size_t SZ_WL = SZ_WIN + SZ_WBA + SZ_WOUT + SZ_WGU + SZ_WDN + SZ_WSB;
constexpr size_t WS_W = WS_CTL + CTL_BYTES;
constexpr size_t OFF_WIN = 0, OFF_WBA = OFF_WIN + SZ_WIN, OFF_WOUT = OFF_WBA + SZ_WBA, OFF_WGU = OFF_WOUT + SZ_WOUT, OFF_WDN = OFF_WGU + SZ_WGU, OFF_WSB = OFF_WDN + SZ_WDN;
constexpr size_t WS_BG = WS_W + DEPTH * SZ_WL;
constexpr size_t WS_SSQ = WS_BG + (size_t)M * 8 * 4;
constexpr size_t WS_HB = WS_SSQ + (size_t)M * 4 * 4;
constexpr size_t WS_R = WS_HB + (size_t)M * D * 2;
constexpr size_t WS_QKV = WS_R;
constexpr size_t WS_OCAT = WS_QKV + (size_t)M * QKV * 2;
constexpr size_t WS_VG = WS_OCAT + (size_t)M * D * 2;
constexpr size_t WS_RING = WS_VG + (size_t)M * 512 * 2;
constexpr size_t WS_HID = WS_R;
constexpr int SL_WN = 0, SL_QG = 16384, SL_KGT = 32768, SL_QK = 49152, SL_UT = 57344, SL_MISC = 73728, SLOT_BYTES = 73984;
constexpr size_t WS_SSAVE = WS_RING + (size_t)32 * NCH * SLOT_BYTES;
constexpr size_t WS_END = WS_SSAVE + (size_t)32 * 512 * 128;
static_assert((size_t)M * DFF * 2 <= WS_RING - WS_R, "hidden overlay fits");
static_assert(WS_END <= 268435456ull, "d_ws map fits 256 MiB");
constexpr int CW_BAR = 4096;
constexpr int CW_FLAG = 16384;
static_assert((CW_FLAG + 2 * 32 * 32 * 16) * 4 <= (int)CTL_BYTES, "ctl words");
constexpr int RING_BYTES = 131072, MISC_OFF = RING_BYTES + 320, LDS_BYTES = 147456;

#define GAS __attribute__((address_space(1)))
#define LAS __attribute__((address_space(3)))
typedef unsigned short bf16;
typedef unsigned v4u __attribute__((ext_vector_type(4)));
typedef unsigned v2u __attribute__((ext_vector_type(2)));
typedef float f32x4 __attribute__((ext_vector_type(4)));
typedef float f32x2 __attribute__((ext_vector_type(2)));
typedef short bf16x8 __attribute__((ext_vector_type(8)));
typedef short bf16x4 __attribute__((ext_vector_type(4)));
typedef GAS unsigned gu32;
#define RLX_AGENT __ATOMIC_RELAXED, __HIP_MEMORY_SCOPE_AGENT
#define LDS_WAIT() asm volatile("s_waitcnt lgkmcnt(0)" ::: "memory")
#define VM_WAIT() asm volatile("s_waitcnt vmcnt(0)" ::: "memory")
__device__ __forceinline__ unsigned pk2(float lo, float hi) { return pg8::cvt_pk_bf16(lo, hi); }
__device__ __forceinline__ float bf_lo(unsigned u) { return __uint_as_float(u << 16); }
__device__ __forceinline__ float bf_hi(unsigned u) { return __uint_as_float(u & 0xffff0000u); }
__device__ __forceinline__ float bf2f(unsigned short s) { return __uint_as_float((unsigned)s << 16); }
__device__ __forceinline__ float wave_sum(float v) {
#pragma unroll
    for (int o = 1; o < 64; o <<= 1) v += __shfl_xor(v, o);
    return v;
}
__device__ __forceinline__ bf16x8 mk8(v2u a, v2u b) { v4u t; t.x = a.x; t.y = a.y; t.z = b.x; t.w = b.y; return __builtin_bit_cast(bf16x8, t); }
__device__ __forceinline__ v2u pk4(f32x4 v) { v2u r; r.x = pk2(v[0], v[1]); r.y = pk2(v[2], v[3]); return r; }
__device__ __forceinline__ v2u pk4n(f32x4 v) { v2u r; r.x = pk2(-v[0], -v[1]); r.y = pk2(-v[2], -v[3]); return r; }
#define MFMA16(a, b, c) __builtin_amdgcn_mfma_f32_16x16x32_bf16((a), (b), (c), 0, 0, 0)
__device__ __forceinline__ void st16_wt(__amdgpu_buffer_rsrc_t r, unsigned off, v4u v) { __builtin_amdgcn_raw_buffer_store_b128(v, r, (int)off, 0, 16); }

#define XB_TMO      128
#define XB_XCNT(j)  (256  + 64 * (j))
#define XB_XSUB(j)  (1280 + 64 * (j))
#define XB_XGEN(j)  (2304 + 64 * (j))
#define XB_TOP      3328
#define XB_TOPGEN   3392
#define XCD_BAR_WORDS 3456
#define XB_SPIN_CAP (1u << 18)
__device__ __forceinline__ unsigned xb_ld(unsigned* p)              { return __hip_atomic_load(p, __ATOMIC_RELAXED, __HIP_MEMORY_SCOPE_AGENT); }
__device__ __forceinline__ unsigned xb_add(unsigned* p, unsigned v) { return __hip_atomic_fetch_add(p, v, __ATOMIC_RELAXED, __HIP_MEMORY_SCOPE_AGENT); }
__device__ __forceinline__ unsigned xb_xcc_id() { return (unsigned)__builtin_amdgcn_s_getreg((3 << 11) | 20) & 0xFu; }
#define XB_SPIN(cond, bar) do { unsigned _sp = 0; while (cond) { __builtin_amdgcn_s_sleep(1); \
    if ((++_sp & 255u) == 0u) { if (xb_ld(&(bar)[XB_TMO])) break; if (_sp > XB_SPIN_CAP) { atomicAdd(&(bar)[XB_TMO], 1u); break; } } } } while (0)
struct XcdBarrier { unsigned* bar; unsigned x; volatile LAS unsigned* st; };
__device__ __forceinline__ XcdBarrier xcd_barrier_post(unsigned* bar, volatile LAS unsigned* st) {
    XcdBarrier b; b.bar = bar; b.x = xb_xcc_id(); b.st = st;
    if (threadIdx.x == 0) (void)xb_add(&bar[XB_XCNT(b.x)], 1u);
    return b;
}
__device__ __forceinline__ void xcd_barrier_complete(unsigned* bar, unsigned x, unsigned& nloc, unsigned& nx) {
    const unsigned G = gridDim.x * gridDim.y * gridDim.z;
    unsigned sum, cnt, mine, sp = 0u;
    for (;;) {
        sum = 0u; cnt = 0u; mine = 0u;
#pragma unroll
        for (unsigned j = 0; j < 16; ++j) { const unsigned c = xb_ld(&bar[XB_XCNT(j)]); sum += c; cnt += (c > 0u) ? 1u : 0u; mine = (j == x) ? c : mine; }
        if (sum == G) break;
        __builtin_amdgcn_s_sleep(1);
        if ((++sp & 255u) == 0u) { if (xb_ld(&bar[XB_TMO])) break; if (sp > XB_SPIN_CAP) { atomicAdd(&bar[XB_TMO], 1u); break; } }
    }
    nloc = mine > 0u ? mine : 1u; nx = cnt > 0u ? cnt : 1u;
}
__device__ __forceinline__ void xcd_barrier(const XcdBarrier& b, const int wave_id) {
    asm volatile("s_waitcnt vmcnt(0)" ::: "memory");
    __syncthreads();
    if (wave_id == 0 && __builtin_amdgcn_mbcnt_hi(~0u, __builtin_amdgcn_mbcnt_lo(~0u, 0u)) == 0u) {
        unsigned* bar = b.bar;
        __builtin_amdgcn_s_waitcnt(0);
        unsigned nloc = b.st[0], nx = b.st[1];
        if (nloc == 0u) { xcd_barrier_complete(bar, b.x, nloc, nx); b.st[0] = nloc; b.st[1] = nx; }
        const unsigned old = xb_add(&bar[XB_XSUB(b.x)], 1u);
        const unsigned gen = old / nloc;
        if (old + 1u == (gen + 1u) * nloc) {
            __builtin_amdgcn_fence(__ATOMIC_RELEASE, "agent");
            asm volatile("s_waitcnt vmcnt(0)" ::: "memory");
            const unsigned og = xb_add(&bar[XB_TOP], 1u);
            const unsigned tg = og / nx;
            if (og + 1u == (tg + 1u) * nx) xb_add(&bar[XB_TOPGEN], 1u);
            else XB_SPIN(xb_ld(&bar[XB_TOPGEN]) == tg, bar);
            __builtin_amdgcn_fence(__ATOMIC_ACQUIRE, "agent");
            xb_add(&bar[XB_XGEN(b.x)], 1u);
            asm volatile("s_waitcnt vmcnt(0)" ::: "memory");
        } else {
            XB_SPIN(xb_ld(&bar[XB_XGEN(b.x)]) == gen, bar);
            __builtin_amdgcn_fence(__ATOMIC_ACQUIRE, "agent");
            asm volatile("s_waitcnt vmcnt(0)" ::: "memory");
        }
    }
    __syncthreads();
}

struct Args { const float* in[17]; float* out; unsigned char* ws; int ph_lo, ph_hi; };
#define CAS __attribute__((address_space(4)))
struct Frame {
    LAS unsigned char* lds;
    int tid, lane, wave, G, vcu;
    const CAS Args* A;
};
struct LayerW { bf16 *win, *wba, *wout, *wgu, *wdn, *wsb; };
__device__ __forceinline__ LayerW layer_w(unsigned char* ws, int l) {
    unsigned char* b = ws + WS_W + (size_t)l * SZ_WL; LayerW w;
    w.win = (bf16*)(b + OFF_WIN); w.wba = (bf16*)(b + OFF_WBA); w.wout = (bf16*)(b + OFF_WOUT); w.wgu = (bf16*)(b + OFF_WGU); w.wdn = (bf16*)(b + OFF_WDN); w.wsb = (bf16*)(b + OFF_WSB);
    return w;
}

__device__ __forceinline__ void p0_transpose_item(const float* W, int K, int N, int k0, int nsrc0, bf16* WT, int drow0, const float* scale, LAS float* scr, int lane) {
#pragma unroll 8
    for (int i = 0; i < 32; ++i) { const int kk = 2 * i + (lane >> 5); float v = W[(size_t)(k0 + kk) * N + nsrc0 + (lane & 31)]; if (scale) v *= scale[k0 + kk]; scr[kk * 33 + (lane & 31)] = v; }
    LDS_WAIT(); asm volatile("" ::: "memory");
    const int c = lane & 7;
#pragma unroll
    for (int j = 0; j < 4; ++j) { const int n = (lane >> 3) + 8 * j; const LAS float* s = scr + (8 * c) * 33 + n;
        v4u o; o.x = pk2(s[0 * 33], s[1 * 33]); o.y = pk2(s[2 * 33], s[3 * 33]); o.z = pk2(s[4 * 33], s[5 * 33]); o.w = pk2(s[6 * 33], s[7 * 33]);
        *(GAS v4u*)(WT + (size_t)(drow0 + n) * K + k0 + 8 * c) = o; }
    LDS_WAIT(); asm volatile("" ::: "memory");
}
__device__ __forceinline__ void p0_prologue(Frame& F) {
    LAS float* scr = (LAS float*)(F.lds + F.wave * 16384);
    const int gw = F.vcu * NWAVES + F.wave, NGW = F.G * NWAVES;
    constexpr int I_IN = (D / 64) * (NPROJ / 32), I_OUT = (D / 64) * (D / 32), I_GU = (D / 64) * (NGU / 32), I_DN = (DFF / 64) * (D / 32), I_L = I_IN + I_OUT + I_GU + I_DN;
    for (int it = gw; it < DEPTH * I_L; it += NGW) {
        const int l = it / I_L; int r = it % I_L; const LayerW w = layer_w(F.A->ws, l);
        if (r < I_IN) { const int nb = r % (NPROJ / 32), kb = r / (NPROJ / 32); const int nd = nb * 32, ns = nd + (nd >= 2048 ? 8 : 0);
            p0_transpose_item(F.A->in[2] + (size_t)l * D * IN_DIM, D, IN_DIM, kb * 64, ns, w.win, nd, F.A->in[1] + l * D, scr, F.lane); continue; } r -= I_IN;
        if (r < I_OUT) { const int nb = r % (D / 32), kb = r / (D / 32);
            p0_transpose_item(F.A->in[11] + (size_t)l * D * D, D, D, kb * 64, nb * 32, w.wout, nb * 32, nullptr, scr, F.lane); continue; } r -= I_OUT;
        if (r < I_GU) { const int nb = r % (NGU / 32), kb = r / (NGU / 32); const int tile = nb >> 3, j = nb & 7;
            const float* src = (j < 4 ? F.A->in[13] : F.A->in[14]) + (size_t)l * D * DFF;
            p0_transpose_item(src, D, DFF, kb * 64, tile * 128 + (j & 3) * 32, w.wgu, nb * 32, F.A->in[12] + l * D, scr, F.lane); continue; } r -= I_GU;
        { const int nb = r % (D / 32), kb = r / (D / 32);
            p0_transpose_item(F.A->in[15] + (size_t)l * DFF * D, DFF, D, kb * 64, nb * 32, w.wdn, nb * 32, nullptr, scr, F.lane); }
    }
    const int gt = F.vcu * (NWAVES * 64) + F.tid, NGT = F.G * NWAVES * 64;
    for (int i = gt; i < DEPTH * 16 * D; i += NGT) { const int l = i / (16 * D), j = (i / D) & 15, k = i % D;
        const float v = j < 8 ? F.A->in[2][(size_t)l * D * IN_DIM + (size_t)k * IN_DIM + 2048 + j] * F.A->in[1][l * D + k] : 0.f;
        layer_w(F.A->ws, l).wba[j * D + k] = (bf16)(pk2(v, 0.f) & 0xffffu); }
    for (int i = gt; i < DEPTH * 4 * 128 * 128; i += NGT) { const int l = i / (4 * 128 * 128), e = i % (4 * 128 * 128), t = (e >> 7) & 127, s = e & 127;
        const float v = (t >= s) ? F.A->in[9][i] : 0.f; layer_w(F.A->ws, l).wsb[e] = (bf16)(pk2(v, 0.f) & 0xffffu); }
    bf16* hb = (bf16*)(F.A->ws + WS_HB); float* ssq = (float*)(F.A->ws + WS_SSQ);
    for (int m = gw; m < M; m += NGW) {
        const GAS f32x4* xr = (const GAS f32x4*)(F.A->in[0] + (size_t)m * D) + F.lane; f32x4 v[4]; float s = 0.f;
#pragma unroll
        for (int j = 0; j < 4; ++j) { v[j] = xr[64 * j]; s += (v[j].x * v[j].x + v[j].y * v[j].y) + (v[j].z * v[j].z + v[j].w * v[j].w); }
        s = wave_sum(s);
        GAS v2u* o8 = (GAS v2u*)(hb + (size_t)m * D) + F.lane;
#pragma unroll
        for (int j = 0; j < 4; ++j) { v2u o; o.x = pk2(v[j].x, v[j].y); o.y = pk2(v[j].z, v[j].w); o8[64 * j] = o; }
        if (F.lane == 0) *(GAS f32x4*)(ssq + (size_t)m * 4) = (f32x4){s, 0.f, 0.f, 0.f};
    }
}

__device__ __forceinline__ void ba_rows(Frame& F, int l, int row0) {
    const bf16* hb = (const bf16*)(F.A->ws + WS_HB); const bf16* wba = layer_w(F.A->ws, l).wba; const float* ssq = (const float*)(F.A->ws + WS_SSQ); float* bg = (float*)(F.A->ws + WS_BG);
    const int fr = F.lane & 15, fq = F.lane >> 4, w = F.wave;
    f32x4 acc[4];
#pragma unroll
    for (int m = 0; m < 4; ++m) acc[m] = (f32x4){0.f, 0.f, 0.f, 0.f};
#pragma unroll
    for (int ks = 0; ks < 4; ++ks) { const int k0 = 128 * w + 32 * ks + 8 * fq;
        const bf16x8 b = *(const GAS bf16x8*)(wba + (size_t)fr * D + k0);
#pragma unroll
        for (int m = 0; m < 4; ++m) { const bf16x8 a = *(const GAS bf16x8*)(hb + (size_t)(row0 + 16 * m + fr) * D + k0); acc[m] = MFMA16(a, b, acc[m]); } }
    LAS float* part = (LAS float*)F.lds;
#pragma unroll
    for (int m = 0; m < 4; ++m)
#pragma unroll
        for (int r = 0; r < 4; ++r) part[(w * 64 + 16 * m + 4 * fq + r) * 16 + fr] = acc[m][r];
    LDS_WAIT(); __syncthreads();
    { const int row = F.tid >> 3, j = F.tid & 7; float s = 0.f;
#pragma unroll
      for (int ww = 0; ww < 8; ++ww) s += part[(ww * 64 + row) * 16 + j];
      s *= pg8::row_rs(ssq, row0 + row);
      float o;
      if (j < 4) o = 1.0f / (1.0f + __expf(-s));
      else { const float z = s + F.A->in[5][l * 4 + (j - 4)]; const float sp = z > 20.f ? z : log1pf(__expf(z)); o = -__expf(F.A->in[4][l * 4 + (j - 4)]) * sp; }
      bg[(size_t)(row0 + row) * 8 + j] = o; }
    __syncthreads();
}

constexpr int PK_KB = 0, PK_QB = 17408, PK_VT = 34816, PK_KT = 69632, PK_AF = 104448, PK_TD = 121856, PK_GC = 124928, PK_QKT = 132096;
constexpr int SC_W = 0, SC_Q = 17408, SC_K = 34816, SC_QK = 53248, SC_O = 62464;

__device__ __forceinline__ void delta_prep_item(Frame& F, int l, int b, int h, int n, unsigned char* slot, gu32* flag) {
    const __amdgpu_buffer_rsrc_t srs = __builtin_amdgcn_make_buffer_rsrc(slot, 0, SLOT_BYTES, 0x00020000);
    const bf16* qkv = (const bf16*)(F.A->ws + WS_QKV); const float* bg = (const float*)(F.A->ws + WS_BG); const float* convw = F.A->in[3] + (size_t)l * 4 * QKV;
    LAS unsigned char* L = F.lds; int lane_ = F.lane; asm volatile("" : "+v"(lane_));
    const int lane = lane_, w = F.wave, tid = w * 64 + lane, fr = lane & 15, fq = lane >> 4;
    const int t0 = n * CH, R0 = b * T + t0;
    float gc, bval;
    { const float gv = bg[(size_t)(R0 + lane) * 8 + 4 + h]; bval = bg[(size_t)(R0 + lane) * 8 + h]; gc = gv;
#pragma unroll
      for (int o = 1; o < 64; o <<= 1) { const float t = __shfl_up(gc, o); if (lane >= o) gc += t; } }
    const float glast = __shfl(gc, 63);
    if (w == 0) { ((LAS float*)(L + PK_GC))[lane] = gc; ((LAS float*)(L + PK_GC))[64 + lane] = bval; }
    float eg[8], ek[8], be[8];
#pragma unroll
    for (int i = 0; i < 8; ++i) { const float g_i = __shfl(gc, 8 * w + i); eg[i] = __expf(g_i); ek[i] = __expf(glast - g_i); be[i] = __shfl(bval, 8 * w + i); }
#ifndef SK_A
    const int ch = 2 * lane;
#pragma unroll 1
    for (int X = 0; X < 3; ++X) { const int XX = (X == 0) ? 1 : (X == 1 ? 0 : 2);
        const int colx = XX * 512 + h * 128 + ch;
        float cw0[4], cw1[4];
#pragma unroll
        for (int j = 0; j < 4; ++j) { const f32x2 c2 = *(const GAS f32x2*)(convw + (size_t)j * QKV + colx); cw0[j] = c2.x; cw1[j] = c2.y; }
        float x0[11], x1[11];
#pragma unroll
        for (int rr = 0; rr < 11; ++rr) { const int tt = t0 + 8 * w + rr - 3; unsigned u = 0u; if (tt >= 0) u = *(const GAS unsigned*)(qkv + (size_t)(R0 + 8 * w + rr - 3) * QKV + colx); x0[rr] = bf_lo(u); x1[rr] = bf_hi(u); }
        float y0[8], y1[8];
#pragma unroll
        for (int i = 0; i < 8; ++i) { float a0 = 0.f, a1 = 0.f;
#pragma unroll
            for (int j = 0; j < 4; ++j) { a0 += cw0[j] * x0[i + j]; a1 += cw1[j] * x1[i + j]; }
            y0[i] = pg8::silu_f(a0); y1[i] = pg8::silu_f(a1); }
        if (XX < 2) {
#pragma unroll
            for (int i = 0; i < 8; ++i) { const float sq = wave_sum(y0[i] * y0[i] + y1[i] * y1[i]); const float rn = (XX == 0 ? 0.08838834764831845f : 1.0f) / sqrtf(sq + 1e-6f); y0[i] *= rn; y1[i] *= rn; } }
        if (XX == 0) {
#pragma unroll
            for (int i = 0; i < 8; ++i) { const int c = 8 * w + i;
                *(LAS unsigned*)(L + PK_QB + c * 272 + ch * 2) = pk2(y0[i], y1[i]); }
        } else if (XX == 1) {
#pragma unroll
            for (int i = 0; i < 8; ++i) { const int c = 8 * w + i; *(LAS unsigned*)(L + PK_KB + c * 272 + ch * 2) = pk2(y0[i], y1[i]); }
            { v4u kg; kg.x = pk2(y0[0] * ek[0], y0[1] * ek[1]); kg.y = pk2(y0[2] * ek[2], y0[3] * ek[3]); kg.z = pk2(y0[4] * ek[4], y0[5] * ek[5]); kg.w = pk2(y0[6] * ek[6], y0[7] * ek[7]);
              st16_wt(srs, SL_KGT + ((ch) * 64 + 8 * w) * 2, kg);
              kg.x = pk2(y1[0] * ek[0], y1[1] * ek[1]); kg.y = pk2(y1[2] * ek[2], y1[3] * ek[3]); kg.z = pk2(y1[4] * ek[4], y1[5] * ek[5]); kg.w = pk2(y1[6] * ek[6], y1[7] * ek[7]);
              st16_wt(srs, SL_KGT + ((ch + 1) * 64 + 8 * w) * 2, kg); }
            LAS float* kt = (LAS float*)(L + PK_KT + ch * 272 + 8 * w * 4);
            *(LAS f32x4*)kt = (f32x4){y0[0] * be[0] * eg[0], y0[1] * be[1] * eg[1], y0[2] * be[2] * eg[2], y0[3] * be[3] * eg[3]};
            *(LAS f32x4*)(kt + 4) = (f32x4){y0[4] * be[4] * eg[4], y0[5] * be[5] * eg[5], y0[6] * be[6] * eg[6], y0[7] * be[7] * eg[7]};
            *(LAS f32x4*)(kt + 68) = (f32x4){y1[0] * be[0] * eg[0], y1[1] * be[1] * eg[1], y1[2] * be[2] * eg[2], y1[3] * be[3] * eg[3]};
            *(LAS f32x4*)(kt + 72) = (f32x4){y1[4] * be[4] * eg[4], y1[5] * be[5] * eg[5], y1[6] * be[6] * eg[6], y1[7] * be[7] * eg[7]};
        } else {
            LAS float* vt = (LAS float*)(L + PK_VT + ch * 272 + 8 * w * 4);
            *(LAS f32x4*)vt = (f32x4){y0[0] * be[0], y0[1] * be[1], y0[2] * be[2], y0[3] * be[3]};
            *(LAS f32x4*)(vt + 4) = (f32x4){y0[4] * be[4], y0[5] * be[5], y0[6] * be[6], y0[7] * be[7]};
            *(LAS f32x4*)(vt + 68) = (f32x4){y1[0] * be[0], y1[1] * be[1], y1[2] * be[2], y1[3] * be[3]};
            *(LAS f32x4*)(vt + 72) = (f32x4){y1[4] * be[4], y1[5] * be[5], y1[6] * be[6], y1[7] * be[7]};
        }
        asm volatile("" ::: "memory");
    }
#endif
    if (tid == 0) st16_wt(srs, SL_MISC, (v4u){__float_as_uint(__expf(glast)), 0u, 0u, 0u});
    LDS_WAIT(); __syncthreads();
    const LAS float* GC = (const LAS float*)(L + PK_GC); const LAS float* BE = GC + 64;
#ifndef SK_B1
    for (int fi = w; fi < 10; fi += 8) { const int mb = fi >= 6 ? 3 : (fi >= 3 ? 2 : (fi >= 1 ? 1 : 0)), sb = fi - (mb * (mb + 1)) / 2;
        f32x4 acc = (f32x4){0.f, 0.f, 0.f, 0.f};
#pragma unroll
        for (int ks = 0; ks < 4; ++ks) { const bf16x8 a = *(const LAS bf16x8*)(L + PK_KB + (16 * mb + fr) * 272 + (32 * ks + 8 * fq) * 2); const bf16x8 bb = *(const LAS bf16x8*)(L + PK_KB + (16 * sb + fr) * 272 + (32 * ks + 8 * fq) * 2); acc = MFMA16(a, bb, acc); }
        const int s = 16 * sb + fr; const float gs = GC[s];
#pragma unroll
        for (int r = 0; r < 4; ++r) { const int c = 16 * mb + 4 * fq + r; const float v = (c > s) ? acc[r] * BE[c] * __expf(fminf(GC[c] - gs, 0.f)) : 0.f; ((LAS float*)(L + PK_AF))[c * 68 + s] = v; } }
#endif
    LDS_WAIT(); __syncthreads();
#ifndef SK_C
    if (w < 4) { const int cc = fr; float t[16];
#pragma unroll
        for (int j = 0; j < 16; ++j) t[j] = (j == cc) ? 1.f : 0.f;
#pragma unroll
        for (int r = 1; r < 16; ++r) { const LAS f32x4* arow = (const LAS f32x4*)((const LAS float*)(L + PK_AF) + (16 * w + r) * 68 + 16 * w); float a = t[r];
            f32x4 av[4];
#pragma unroll
            for (int j4 = 0; j4 < 4; ++j4) if (4 * j4 < r) av[j4] = arow[j4];
#pragma unroll
            for (int j = 0; j < r; ++j) a -= av[j >> 2][j & 3] * t[j];
            t[r] = a; asm volatile("" ::: "memory"); }
        if (lane < 16) {
#pragma unroll
            for (int r = 0; r < 16; ++r) *(LAS unsigned short*)(L + PK_TD + (16 * w + r) * 48 + cc * 2) = (unsigned short)(pk2(r == cc ? 0.f : t[r], 0.f) & 0xffffu); }
    } else { const int mb = w - 4; const int c = 16 * mb + fr; const float gcc = GC[c];
#pragma unroll 1
        for (int sb = 0; sb < 4; ++sb) { v2u o; o.x = 0u; o.y = 0u;
            if (sb <= mb) { f32x4 acc = (f32x4){0.f, 0.f, 0.f, 0.f};
#pragma unroll
                for (int ks = 0; ks < 4; ++ks) { const bf16x8 kf = *(const LAS bf16x8*)(L + PK_KB + (16 * sb + fr) * 272 + (32 * ks + 8 * fq) * 2); const bf16x8 qf = *(const LAS bf16x8*)(L + PK_QB + (16 * mb + fr) * 272 + (32 * ks + 8 * fq) * 2); acc = MFMA16(kf, qf, acc); }
                f32x4 v;
#pragma unroll
                for (int r = 0; r < 4; ++r) { const int s = 16 * sb + 4 * fq + r; v[r] = (c >= s) ? acc[r] * __expf(fminf(gcc - GC[s], 0.f)) : 0.f; }
                o = pk4(v); }
            *(LAS v2u*)(L + PK_QKT + c * 144 + (16 * sb + 4 * fq) * 2) = o; } }
#endif
    LDS_WAIT(); __syncthreads();
#ifndef SK_D
    {
        const LAS float* AF = (const LAS float*)(L + PK_AF);
        const v2u z2 = (v2u){0u, 0u};
        bf16x8 td[4];
#pragma unroll
        for (int bb = 0; bb < 4; ++bb) td[bb] = mk8(*(const LAS v2u*)(L + PK_TD + (16 * bb + fr) * 48 + 4 * fq * 2), z2);
        const bf16x8 a10 = mk8(pk4n(*(const LAS f32x4*)(AF + (16 + fr) * 68 + 4 * fq)), z2);
        const bf16x8 a2x = mk8(pk4n(*(const LAS f32x4*)(AF + (32 + fr) * 68 + 4 * fq)), pk4n(*(const LAS f32x4*)(AF + (32 + fr) * 68 + 16 + 4 * fq)));
        const bf16x8 a3a = mk8(pk4n(*(const LAS f32x4*)(AF + (48 + fr) * 68 + 4 * fq)), pk4n(*(const LAS f32x4*)(AF + (48 + fr) * 68 + 16 + 4 * fq)));
        const bf16x8 a3b = mk8(pk4n(*(const LAS f32x4*)(AF + (48 + fr) * 68 + 32 + 4 * fq)), z2);
#pragma unroll
        for (int f = 0; f < 2; ++f) { const int n0 = 32 * w + 16 * f; const bool isU = n0 < 128; const int col = (n0 & 127) + fr;
            const LAS float* img = (const LAS float*)(L + (isU ? PK_VT : PK_KT) + col * 272);
            f32x4 X0 = *(const LAS f32x4*)(img + 4 * fq), X1 = *(const LAS f32x4*)(img + 16 + 4 * fq), X2 = *(const LAS f32x4*)(img + 32 + 4 * fq), X3 = *(const LAS f32x4*)(img + 48 + 4 * fq);
            X0 = MFMA16(td[0], mk8(pk4(X0), z2), X0);
            X1 = MFMA16(a10, mk8(pk4(X0), z2), X1); X1 = MFMA16(td[1], mk8(pk4(X1), z2), X1);
            const bf16x8 x01 = mk8(pk4(X0), pk4(X1));
            X2 = MFMA16(a2x, x01, X2); X2 = MFMA16(td[2], mk8(pk4(X2), z2), X2);
            X3 = MFMA16(a3a, x01, X3); X3 = MFMA16(a3b, mk8(pk4(X2), z2), X3); X3 = MFMA16(td[3], mk8(pk4(X3), z2), X3);
            if (isU) { LAS unsigned char* up = L + PK_VT + col * 272 + 4 * fq * 2;
                *(LAS v2u*)(up) = pk4(X0); *(LAS v2u*)(up + 32) = pk4(X1); *(LAS v2u*)(up + 64) = pk4(X2); *(LAS v2u*)(up + 96) = pk4(X3); }
            else { LAS unsigned char* wp = L + PK_KB + (4 * fq) * 272 + col * 2;
#pragma unroll
                for (int r = 0; r < 4; ++r) { *(LAS unsigned short*)(wp + (r) * 272) = (unsigned short)(pk2(-X0[r], 0.f) & 0xffffu); *(LAS unsigned short*)(wp + (16 + r) * 272) = (unsigned short)(pk2(-X1[r], 0.f) & 0xffffu);
                    *(LAS unsigned short*)(wp + (32 + r) * 272) = (unsigned short)(pk2(-X2[r], 0.f) & 0xffffu); *(LAS unsigned short*)(wp + (48 + r) * 272) = (unsigned short)(pk2(-X3[r], 0.f) & 0xffffu); } }
        }
    }
#endif
    LDS_WAIT(); __syncthreads();
#pragma unroll
    for (int i = 0; i < 2; ++i) { const int idx = tid + 512 * i, row = idx >> 4, c16 = idx & 15;
        st16_wt(srs, SL_WN + row * 256 + c16 * 16, *(const LAS v4u*)(L + PK_KB + row * 272 + c16 * 16));
        const v4u q = *(const LAS v4u*)(L + PK_QB + row * 272 + c16 * 16); const float e = __expf(GC[row]);
        st16_wt(srs, SL_QG + row * 256 + c16 * 16, (v4u){pk2(bf_lo(q.x) * e, bf_hi(q.x) * e), pk2(bf_lo(q.y) * e, bf_hi(q.y) * e), pk2(bf_lo(q.z) * e, bf_hi(q.z) * e), pk2(bf_lo(q.w) * e, bf_hi(q.w) * e)}); }
#pragma unroll
    for (int i = 0; i < 2; ++i) { const int idx = tid + 512 * i, row = idx >> 3, c16 = idx & 7; st16_wt(srs, SL_UT + row * 128 + c16 * 16, *(const LAS v4u*)(L + PK_VT + row * 272 + c16 * 16)); }
    { const int row = tid >> 3, c16 = tid & 7; st16_wt(srs, SL_QK + row * 128 + c16 * 16, *(const LAS v4u*)(L + PK_QKT + row * 144 + c16 * 16)); }
    asm volatile("s_waitcnt vmcnt(0)" ::: "memory");
    __syncthreads();
    if (tid == 0) __hip_atomic_store(flag, 1u, RLX_AGENT);
}

__device__ __forceinline__ void scan_wait(gu32* flag, gu32* tmo) {
    unsigned sp = 0;
    while ((unsigned)__builtin_amdgcn_readfirstlane(__hip_atomic_load(flag, RLX_AGENT)) == 0u) {
        __builtin_amdgcn_s_sleep(2);
        if ((++sp & 1023u) == 0u) { if (__hip_atomic_load(tmo, RLX_AGENT) != 0u) break; if (sp > (1u << 22)) { __hip_atomic_store(tmo, 1u, RLX_AGENT); break; } } }
    __builtin_amdgcn_fence(__ATOMIC_ACQUIRE, "agent");
    asm volatile("s_waitcnt vmcnt(0)" ::: "memory");
}
struct ScanPre { v4u w[2], q[2], k[2], qk, z0, z1; v2u u[4]; float dl; };
__device__ __forceinline__ void scan_load(ScanPre& P, const unsigned char* slot, const bf16* zrow, int tid, int w, int fr, int fq) {
#pragma unroll
    for (int i = 0; i < 2; ++i) { const int idx = tid + 512 * i;
        P.w[i] = *(const GAS v4u*)(slot + SL_WN + idx * 16); P.q[i] = *(const GAS v4u*)(slot + SL_QG + idx * 16); P.k[i] = *(const GAS v4u*)(slot + SL_KGT + idx * 16); }
    P.qk = *(const GAS v4u*)(slot + SL_QK + tid * 16);
#pragma unroll
    for (int m = 0; m < 4; ++m) P.u[m] = *(const GAS v2u*)(slot + SL_UT + ((16 * w + fr) * 64 + 16 * m + 4 * fq) * 2);
    P.dl = *(const GAS float*)(slot + SL_MISC);
    P.z0 = *(const GAS v4u*)zrow; P.z1 = *(const GAS v4u*)(zrow + 8);
}
__device__ __forceinline__ void delta_scan(Frame& F, int l, int bh) {
    const int b = bh >> 2, h = bh & 3; LAS unsigned char* L = F.lds; const int w = F.wave;
    bf16* ocat = (bf16*)(F.A->ws + WS_OCAT); const float* ong = F.A->in[6] + l * 128;
    gu32* flags = (gu32*)(F.A->ws + WS_CTL) + CW_FLAG + (size_t)((l * 32 + bh) * 32) * 16; gu32* tmo = (gu32*)(F.A->ws + WS_CTL) + CW_BAR + XB_TMO;
    const unsigned char* slot0 = F.A->ws + WS_RING + (size_t)(bh * NCH) * SLOT_BYTES;
    f32x4 S[8];
#pragma unroll
    for (int f = 0; f < 8; ++f) S[f] = (f32x4){0.f, 0.f, 0.f, 0.f};
    ScanPre P;
    { int lane_ = F.lane; asm volatile("" : "+v"(lane_)); const int lane = lane_, tid = w * 64 + lane, fr = lane & 15, fq = lane >> 4;
      if (w == 0) scan_wait(flags, tmo);
      __syncthreads();
      scan_load(P, slot0, ocat + (size_t)(b * T + (tid >> 3)) * D + h * 128 + 16 * (tid & 7), tid, w, fr, fq); }
#pragma unroll 1
    for (int n = 0; n < NCH; ++n) {
        int lane_ = F.lane; asm volatile("" : "+v"(lane_)); const int lane = lane_, tid = w * 64 + lane, fr = lane & 15, fq = lane >> 4;
#pragma unroll
        for (int i = 0; i < 2; ++i) { const int idx = tid + 512 * i;
            *(LAS v4u*)(L + SC_W + (idx >> 4) * 272 + (idx & 15) * 16) = P.w[i]; *(LAS v4u*)(L + SC_Q + (idx >> 4) * 272 + (idx & 15) * 16) = P.q[i];
            *(LAS v4u*)(L + SC_K + (idx >> 3) * 144 + (idx & 7) * 16) = P.k[i]; }
        *(LAS v4u*)(L + SC_QK + (tid >> 3) * 144 + (tid & 7) * 16) = P.qk;
        f32x4 vn[4], o[4];
#pragma unroll
        for (int m = 0; m < 4; ++m) { vn[m] = (f32x4){bf_lo(P.u[m].x), bf_hi(P.u[m].x), bf_lo(P.u[m].y), bf_hi(P.u[m].y)}; o[m] = (f32x4){0.f, 0.f, 0.f, 0.f}; }
        const float dl = P.dl; const v4u zc0 = P.z0, zc1 = P.z1;
        if (n + 1 < NCH && w == 0) scan_wait(flags + (n + 1) * 16, tmo);
        LDS_WAIT(); __syncthreads();
        if (n + 1 < NCH) scan_load(P, slot0 + (size_t)(n + 1) * SLOT_BYTES, ocat + (size_t)(b * T + (n + 1) * CH + (tid >> 3)) * D + h * 128 + 16 * (tid & 7), tid, w, fr, fq);
        bf16x8 Sb[4];
#pragma unroll
        for (int ks = 0; ks < 4; ++ks) Sb[ks] = mk8(pk4(S[2 * ks]), pk4(S[2 * ks + 1]));
#pragma unroll
        for (int m = 0; m < 4; ++m)
#pragma unroll
            for (int ks = 0; ks < 4; ++ks) { const LAS unsigned char* p = L + (16 * m + fr) * 272 + (32 * ks + 4 * fq) * 2;
                vn[m] = MFMA16(mk8(*(const LAS v2u*)(p + SC_W), *(const LAS v2u*)(p + SC_W + 32)), Sb[ks], vn[m]);
                o[m] = MFMA16(mk8(*(const LAS v2u*)(p + SC_Q), *(const LAS v2u*)(p + SC_Q + 32)), Sb[ks], o[m]); }
        bf16x8 Vb[2];
#pragma unroll
        for (int kc = 0; kc < 2; ++kc) Vb[kc] = mk8(pk4(vn[2 * kc]), pk4(vn[2 * kc + 1]));
#pragma unroll
        for (int m = 0; m < 4; ++m)
#pragma unroll
            for (int kc = 0; kc < 2; ++kc) { const LAS unsigned char* p = L + SC_QK + (16 * m + fr) * 144 + (32 * kc + 4 * fq) * 2; o[m] = MFMA16(mk8(*(const LAS v2u*)p, *(const LAS v2u*)(p + 32)), Vb[kc], o[m]); }
#pragma unroll
        for (int f = 0; f < 8; ++f) { S[f] = S[f] * dl;
#pragma unroll
            for (int kc = 0; kc < 2; ++kc) { const LAS unsigned char* p = L + SC_K + (16 * f + fr) * 144 + (32 * kc + 4 * fq) * 2; S[f] = MFMA16(mk8(*(const LAS v2u*)p, *(const LAS v2u*)(p + 32)), Vb[kc], S[f]); } }
#pragma unroll
        for (int m = 0; m < 4; ++m)
#pragma unroll
            for (int r = 0; r < 4; ++r) ((LAS float*)(L + SC_O))[(16 * m + 4 * fq + r) * 132 + 16 * w + fr] = o[m][r];
        LDS_WAIT(); __syncthreads();
        {
            const int row = tid >> 3, seg = tid & 7; const LAS float* orow = (const LAS float*)(L + SC_O) + row * 132 + 16 * seg;
            f32x4 v[4]; float s = 0.f;
#pragma unroll
            for (int j = 0; j < 4; ++j) { v[j] = *(const LAS f32x4*)(orow + 4 * j); s += (v[j].x * v[j].x + v[j].y * v[j].y) + (v[j].z * v[j].z + v[j].w * v[j].w); }
            s += __shfl_xor(s, 1); s += __shfl_xor(s, 2); s += __shfl_xor(s, 4);
            const float rs = 1.0f / sqrtf(s * (1.0f / 128.0f) + 1e-6f);
            bf16* zp = ocat + (size_t)(b * T + n * CH + row) * D + h * 128 + 16 * seg;
            const unsigned zz[8] = {zc0.x, zc0.y, zc0.z, zc0.w, zc1.x, zc1.y, zc1.z, zc1.w}; unsigned oo[8];
#pragma unroll
            for (int j = 0; j < 8; ++j) { const int e = 16 * seg + 2 * j; const float a = v[j >> 1][(2 * j) & 3] * rs * ong[e] * bf_lo(zz[j]); const float c = v[j >> 1][(2 * j + 1) & 3] * rs * ong[e + 1] * bf_hi(zz[j]); oo[j] = pk2(a, c); }
            *(GAS v4u*)zp = (v4u){oo[0], oo[1], oo[2], oo[3]}; *(GAS v4u*)(zp + 8) = (v4u){oo[4], oo[5], oo[6], oo[7]};
        }
    }
    __syncthreads();
}

__device__ __forceinline__ void gmlp_item(Frame& F, int l, int item) {
    const int g = item & 3, n = (item >> 2) & 15, b = item >> 6; const int R0 = b * T + n * GMC;
    const bf16* vg = (const bf16*)(F.A->ws + WS_VG); bf16* ocat = (bf16*)(F.A->ws + WS_OCAT); const bf16* wsb = layer_w(F.A->ws, l).wsb + (size_t)g * 128 * 128;
    const float* lng = F.A->in[7] + l * 512 + g * 128; const float* lnb = F.A->in[8] + l * 512 + g * 128; const float* bs = F.A->in[10] + (size_t)l * 512 + g * 128;
    LAS unsigned char* L = F.lds; int lane_ = F.lane; asm volatile("" : "+v"(lane_)); const int lane = lane_, w = F.wave, fr = lane & 15, fq = lane >> 4;
    { const int ch = 2 * lane; const float g0 = lng[ch], g1 = lng[ch + 1], b0 = lnb[ch], b1 = lnb[ch + 1]; float y0[16], y1[16];
#pragma unroll
      for (int i = 0; i < 16; ++i) { const unsigned u = *(const GAS unsigned*)(vg + (size_t)(R0 + 16 * w + i) * 512 + g * 128 + ch); const float a0 = bf_lo(u), a1 = bf_hi(u);
          const float mu = wave_sum(a0 + a1) * (1.0f / 128.0f); const float d0 = a0 - mu, d1 = a1 - mu; const float var = wave_sum(d0 * d0 + d1 * d1) * (1.0f / 128.0f); const float rs = 1.0f / sqrtf(var + 1e-6f);
          y0[i] = d0 * rs * g0 + b0; y1[i] = d1 * rs * g1 + b1; }
      *(LAS v4u*)(L + ch * 272 + 32 * w) = (v4u){pk2(y0[0], y0[1]), pk2(y0[2], y0[3]), pk2(y0[4], y0[5]), pk2(y0[6], y0[7])};
      *(LAS v4u*)(L + ch * 272 + 32 * w + 16) = (v4u){pk2(y0[8], y0[9]), pk2(y0[10], y0[11]), pk2(y0[12], y0[13]), pk2(y0[14], y0[15])};
      *(LAS v4u*)(L + (ch + 1) * 272 + 32 * w) = (v4u){pk2(y1[0], y1[1]), pk2(y1[2], y1[3]), pk2(y1[4], y1[5]), pk2(y1[6], y1[7])};
      *(LAS v4u*)(L + (ch + 1) * 272 + 32 * w + 16) = (v4u){pk2(y1[8], y1[9]), pk2(y1[10], y1[11]), pk2(y1[12], y1[13]), pk2(y1[14], y1[15])}; }
    LDS_WAIT(); __syncthreads();
    const int t = 16 * w + fr; const int nks = (16 * w + 15) / 32 + 1;
    bf16x8 wf[4];
#pragma unroll
    for (int ks = 0; ks < 4; ++ks) wf[ks] = (ks < nks) ? *(const GAS bf16x8*)(wsb + (size_t)t * 128 + 32 * ks + 8 * fq) : (bf16x8){0, 0, 0, 0, 0, 0, 0, 0};
    const float bst = bs[t];
#pragma unroll
    for (int nf = 0; nf < 8; ++nf) { f32x4 acc = (f32x4){0.f, 0.f, 0.f, 0.f};
#pragma unroll
        for (int ks = 0; ks < 4; ++ks) if (ks < nks) { const bf16x8 vf = *(const LAS bf16x8*)(L + (16 * nf + fr) * 272 + (32 * ks + 8 * fq) * 2); acc = MFMA16(vf, wf[ks], acc); }
        bf16* up = ocat + (size_t)(R0 + t) * D + 512 + g * 128 + 16 * nf + 4 * fq; const v2u u = *(const GAS v2u*)up;
        v2u o; o.x = pk2(bf_lo(u.x) * (acc[0] + bst), bf_hi(u.x) * (acc[1] + bst)); o.y = pk2(bf_lo(u.y) * (acc[2] + bst), bf_hi(u.y) * (acc[3] + bst));
        *(GAS v2u*)up = o; }
    __syncthreads();
}

__device__ __forceinline__ void final_norm(Frame& F) {
    const int gw = F.vcu * NWAVES + F.wave, NGW = F.G * NWAVES; const float* ssq = (const float*)(F.A->ws + WS_SSQ); const float* gn = F.A->in[16];
    f32x4 gv[4];
#pragma unroll
    for (int j = 0; j < 4; ++j) gv[j] = *(const GAS f32x4*)(gn + 4 * F.lane + 256 * j);
    for (int m = gw; m < M; m += NGW) { const float rs = pg8::row_rs(ssq, m); GAS f32x4* xr = (GAS f32x4*)(F.A->out + (size_t)m * D) + F.lane;
#pragma unroll
        for (int j = 0; j < 4; ++j) { f32x4 v = xr[64 * j]; v = v * rs * gv[j]; xr[64 * j] = v; } }
}

__global__ void __launch_bounds__(NWAVES * 64, 2) hyb_fwd(Args args) {
    extern __shared__ __attribute__((aligned(16))) unsigned char lds[];
    Frame F;
    F.lds = (LAS unsigned char*)lds;
    F.tid = threadIdx.x; F.lane = F.tid & 63; F.wave = __builtin_amdgcn_readfirstlane(F.tid >> 6);
    const int wave0 = F.wave;
    F.G = gridDim.x; { const int bx = blockIdx.x; F.vcu = (F.G % 8 == 0) ? (bx % 8) * (F.G / 8) + bx / 8 : bx; }
    F.A = (const CAS Args*)__builtin_amdgcn_kernarg_segment_ptr();
    gu32* ctl = (gu32*)(args.ws + WS_CTL);
    volatile LAS unsigned* MISC = (volatile LAS unsigned*)(F.lds + MISC_OFF);
    for (int u = F.tid; u < 1024 / 4; u += NWAVES * 64) ((LAS unsigned*)(F.lds + RING_BYTES))[u] = 0u;
    __syncthreads();
    const int lo = args.ph_lo, hi = args.ph_hi;
    const bool multi = (hi - lo) > 1;
    XcdBarrier bar; bar.bar = (unsigned*)(ctl + CW_BAR); bar.x = 0; bar.st = nullptr;
    if (multi) bar = xcd_barrier_post((unsigned*)(ctl + CW_BAR), MISC + 8);
#define RELAUNDER() do { int t_ = wave0 * 64 + (int)__builtin_amdgcn_mbcnt_hi(~0u, __builtin_amdgcn_mbcnt_lo(~0u, 0u)); asm volatile("" : "+v"(t_)); F.tid = t_; F.lane = t_ & 63; F.wave = wave0; const CAS Args* a_ = (const CAS Args*)__builtin_amdgcn_kernarg_segment_ptr(); asm volatile("" : "+s"(a_)); F.A = a_; } while (0)
#define IN(k) (lo <= (k) && (k) < hi)
#define SEAM(k) do { if (IN(k) && IN((k) + 1)) xcd_barrier(bar, wave0); } while (0)
#define WSP(off) (F.A->ws + (off))
#ifndef NO_P0
    if (IN(0)) { RELAUNDER(); p0_prologue(F); }
#endif
    SEAM(0);
#pragma unroll 1
    for (int l = 0; l < DEPTH; ++l) { const int pb = 1 + 5 * l;
        if (IN(pb)) {
            RELAUNDER();
#ifndef NO_G1
            { pg8::Gemm g{(bf16*)WSP(WS_HB), layer_w(F.A->ws, l).win, M, NPROJ, D}; pg8::StaticOrder S; S.init(M, NPROJ, F.G, (int)blockIdx.x);
              pg8::EpiProj E{(bf16*)WSP(WS_QKV), (bf16*)WSP(WS_OCAT), (bf16*)WSP(WS_VG), (const float*)WSP(WS_SSQ)};
              pg8::gemm_phase<pg8::EpiProj, pg8::StaticOrder, true, true>(F.lds, g, S, E, wave0); }
#endif
#ifndef NO_BA
            RELAUNDER();
            for (int r0 = 64 * (int)blockIdx.x; r0 < M; r0 += 64 * F.G) ba_rows(F, l, r0);
#endif
        } SEAM(pb);
        if (IN(pb + 1)) {
            RELAUNDER();
            if ((int)blockIdx.x < 32) {
#ifndef NO_DELTA
                delta_scan(F, l, (int)blockIdx.x);
#endif
            } else { const int p = (int)blockIdx.x - 32, np = F.G - 32;
#ifndef NO_DELTA
#pragma unroll 1
                for (int j = p; j < 32 * NCH; j += np) { const int bh = j & 31, n = j >> 5;
                    delta_prep_item(F, l, bh >> 2, bh & 3, n, F.A->ws + WS_RING + (size_t)(bh * NCH + n) * SLOT_BYTES, (gu32*)(F.A->ws + WS_CTL) + CW_FLAG + (size_t)((l * 32 + bh) * 32 + n) * 16); }
#endif
#ifndef NO_GMLP
#pragma unroll 1
                for (int it = p; it < 512; it += np) gmlp_item(F, l, it);
#endif
            }
        } SEAM(pb + 1);
        if (IN(pb + 2)) {
            RELAUNDER();
#ifndef NO_G2
            pg8::Gemm g{(bf16*)WSP(WS_OCAT), layer_w(F.A->ws, l).wout, M, D, D}; pg8::StaticOrder S; S.init(M, D, F.G, (int)blockIdx.x);
            pg8::EpiRes E{l == 0 ? F.A->in[0] : F.A->out, F.A->out, (bf16*)WSP(WS_HB), (float*)WSP(WS_SSQ)};
            pg8::gemm_phase<pg8::EpiRes, pg8::StaticOrder, false, true>(F.lds, g, S, E, wave0);
#endif
        } SEAM(pb + 2);
        if (IN(pb + 3)) {
            RELAUNDER();
#ifndef NO_G3
            pg8::Gemm g{(bf16*)WSP(WS_HB), layer_w(F.A->ws, l).wgu, M, NGU, D}; pg8::StaticOrder S; S.init(M, NGU, F.G, (int)blockIdx.x);
            pg8::EpiSwiglu E{(bf16*)WSP(WS_HID), (const float*)WSP(WS_SSQ)};
            pg8::gemm_phase<pg8::EpiSwiglu, pg8::StaticOrder, true, true>(F.lds, g, S, E, wave0);
#endif
        } SEAM(pb + 3);
        if (IN(pb + 4)) {
            RELAUNDER();
#ifndef NO_G4
            pg8::Gemm g{(bf16*)WSP(WS_HID), layer_w(F.A->ws, l).wdn, M, D, DFF}; pg8::StaticOrder S; S.init(M, D, F.G, (int)blockIdx.x);
            pg8::EpiRes E{F.A->out, F.A->out, (bf16*)WSP(WS_HB), (float*)WSP(WS_SSQ)};
            pg8::gemm_phase<pg8::EpiRes, pg8::StaticOrder, false, true>(F.lds, g, S, E, wave0);
#endif
        } SEAM(pb + 4);
    }
#ifndef NO_FN
    if (IN(11)) { RELAUNDER(); final_norm(F); }
#endif
#undef IN
#undef SEAM
}

extern "C" void kernel_launch(void* const* d_in, const int* in_sizes, int n_in, void* d_out, int out_size, void* d_ws, size_t ws_size, hipStream_t stream) {
    static int grid = 0;
    if (grid == 0) {
        if (n_in != 17 || in_sizes[0] != M * D || out_size != M * D || ws_size < WS_END) { fprintf(stderr, "kernel_launch: unexpected shapes (n_in %d, in0 %d, out %d, ws %zu < %zu)\n", n_in, n_in > 0 ? in_sizes[0] : -1, out_size, ws_size, (size_t)WS_END); grid = -1; return; }
        int dev = 0, cus = 0, per_cu = 0;
        if (hipGetDevice(&dev) != hipSuccess || hipDeviceGetAttribute(&cus, hipDeviceAttributeMultiprocessorCount, dev) != hipSuccess) { grid = -1; return; }
        if (hipFuncSetAttribute((const void*)hyb_fwd, hipFuncAttributeMaxDynamicSharedMemorySize, LDS_BYTES) != hipSuccess) { fprintf(stderr, "kernel_launch: hipFuncSetAttribute failed\n"); grid = -1; return; }
        if (hipOccupancyMaxActiveBlocksPerMultiprocessor(&per_cu, (const void*)hyb_fwd, NWAVES * 64, LDS_BYTES) != hipSuccess || per_cu < 1) { fprintf(stderr, "kernel_launch: occupancy query says %d blocks per CU\n", per_cu); per_cu = 1; }
        (void)hipGetLastError();
        grid = cus;
    }
    if (grid < 0) return;
    (void)hipMemsetAsync((char*)d_ws + WS_CTL, 0, CTL_BYTES, stream);
    Args a{};
    for (int i = 0; i < 17; ++i) a.in[i] = (const float*)d_in[i];
    a.out = (float*)d_out; a.ws = (unsigned char*)d_ws;
    if (MK_N_LAUNCHES == 1) {
        a.ph_lo = 0; a.ph_hi = N_PHASES;
        void* params[] = {&a};
        hipError_t e = hipLaunchCooperativeKernel((const void*)hyb_fwd, dim3(grid), dim3(NWAVES * 64), params, LDS_BYTES, stream);
        if (e != hipSuccess) fprintf(stderr, "kernel_launch: cooperative launch failed: %s (grid %d)\n", hipGetErrorString(e), grid);
    } else {
        for (int p = 0; p < N_PHASES; ++p) { a.ph_lo = p; a.ph_hi = p + 1; hipLaunchKernelGGL(hyb_fwd, dim3(grid), dim3(NWAVES * 64), LDS_BYTES, stream, a); }
    }
}
```

```cpp
#include <hip/hip_runtime.h>
#include <cstdio>
#include <cstdint>
namespace pg8 {
#define PG8_LAS __attribute__((address_space(3)))
typedef unsigned short bf16_t;
typedef short bf16x8 __attribute__((ext_vector_type(8)));
typedef float f32x4 __attribute__((ext_vector_type(4)));
typedef unsigned u32x4 __attribute__((ext_vector_type(4)));
constexpr int BM = 256, BK = 64, HALF = 128, HTB = HALF * BK * 2  , STAGE_BYTES = 8 * HTB, NXCD = 8, WGM = 8;

__host__ __device__ __forceinline__ int lds_byte(int r, int c) { const int st = (r >> 4) * 2 + (c >> 5), rr = r & 15, cc = c & 31, ob = rr * 64 + cc * 2; return st * 1024 + (ob ^ (((ob >> 9) & 1) << 5)); }
__host__ __device__ __forceinline__ void stage_rc(int b, int& R, int& C) { const int st = b / 1024, sb = b % 1024, swz = sb ^ (((sb >> 9) & 1) << 5); R = (st >> 1) * 16 + swz / 64; C = (st & 1) * 32 + (swz % 64) / 2; }
__host__ __device__ __forceinline__ int perm32(int rho) { const int n = rho >> 4, i = rho & 15; return 8 * (i >> 2) + 4 * n + (i & 3); }

struct Unit { int pm, pn; };
struct Gemm { const bf16_t* A; const bf16_t* Bt; int M, N, K; };

struct StaticOrder {
    int nM, nN, nwg, G, c;
    __host__ __device__ void init(int M, int N, int G_, int c_) { nM = M / BM; nN = N / BM; nwg = nM * nN; G = G_; c = c_; }
    __host__ __device__ bool next(int i, Unit& u) const {
        const long L = (long)i * G + c; if (L >= nwg) return false;
        int wgid = (int)L; { const int q = nwg / NXCD, r = nwg % NXCD, xcd = wgid % NXCD, off = wgid / NXCD; wgid = (xcd < r ? xcd * (q + 1) : r * (q + 1) + (xcd - r) * q) + off; }
        const int nig = WGM * nN, gid = wgid / nig, fm = gid * WGM, gsz = (nM - fm) < WGM ? (nM - fm) : WGM;
        u.pm = fm + ((wgid % nig) % gsz); u.pn = (wgid % nig) / gsz; return true;
    }
    __device__ __forceinline__ void a_ready(const Unit&) const {}
    __device__ __forceinline__ void done(const Unit&) const {}
};

typedef float f32x2_t __attribute__((ext_vector_type(2))); typedef __bf16 bf16x2_t __attribute__((ext_vector_type(2)));
__device__ __forceinline__ unsigned cvt_pk_bf16(float lo, float hi) { f32x2_t v = {lo, hi}; bf16x2_t b = __builtin_convertvector(v, bf16x2_t); return __builtin_bit_cast(unsigned, b); }
typedef float f32x2 __attribute__((ext_vector_type(2)));
typedef unsigned u32x2 __attribute__((ext_vector_type(2)));
constexpr float RMS_EPS = 1e-6f;
__device__ __forceinline__ float fast_sigmoid(float x) { return __builtin_amdgcn_rcpf(1.0f + __builtin_amdgcn_exp2f(-1.4426950408889634f * x)); }
__device__ __forceinline__ float silu_f(float x) { return x * fast_sigmoid(x); }
__device__ __forceinline__ float gelu_tanh_f(float x) { const float z = 1.5957691216057308f * (x + 0.044715f * x * x * x); return x * fast_sigmoid(z); }
__device__ __forceinline__ float row_rs(const float* ssq, int row) { const f32x4 s = *(const f32x4*)(ssq + (size_t)row * 4); return 1.0f / sqrtf(((s[0] + s[1]) + (s[2] + s[3])) * (1.0f / 1024.0f) + RMS_EPS); }

struct EpiProj {
    static constexpr bool PERM = true, AFTER_DRAIN = false;
    bf16_t* qkv; bf16_t* ocat; bf16_t* vg; const float* ssq;
    __device__ __forceinline__ void operator()(const f32x4 (&acc)[2][2][4][2], const Unit& u, int wr, int wc, int fr, int fq) const {
        const int pn = u.pn; bf16_t* base; int ldc, colt, act;
        if (pn < 6) { base = qkv; ldc = 1536; colt = 256 * pn; act = 0; }
        else if (pn < 8) { base = ocat; ldc = 1024; colt = 256 * (pn - 6); act = 1; }
        else if (pn < 10) { base = ocat; ldc = 1024; colt = 512 + 256 * (pn - 8); act = 2; }
        else { base = vg; ldc = 512; colt = 256 * (pn - 10); act = 2; }
        const int row0 = u.pm * BM + wr * 64 + fr, col0 = colt + wc * 32 + 8 * fq;
#pragma unroll
        for (int ai = 0; ai < 2; ++ai)
#pragma unroll
            for (int m = 0; m < 4; ++m) { const int r = row0 + ai * HALF + m * 16; const float rs = row_rs(ssq, r); bf16_t* rowp = base + (size_t)r * ldc + col0;
#pragma unroll
                for (int bj = 0; bj < 2; ++bj) { f32x4 v0 = acc[ai][bj][m][0] * rs, v1 = acc[ai][bj][m][1] * rs;
                    if (act == 1) {
#pragma unroll
                        for (int e = 0; e < 4; ++e) { v0[e] = silu_f(v0[e]); v1[e] = silu_f(v1[e]); } }
                    else if (act == 2) {
#pragma unroll
                        for (int e = 0; e < 4; ++e) { v0[e] = gelu_tanh_f(v0[e]); v1[e] = gelu_tanh_f(v1[e]); } }
                    u32x4 w; w.x = cvt_pk_bf16(v0[0], v0[1]); w.y = cvt_pk_bf16(v0[2], v0[3]); w.z = cvt_pk_bf16(v1[0], v1[1]); w.w = cvt_pk_bf16(v1[2], v1[3]);
                    *(u32x4*)(rowp + bj * HALF) = w; } }
    }
};

struct EpiSwiglu {
    static constexpr bool PERM = true, AFTER_DRAIN = false;
    bf16_t* hid; const float* ssq;
    __device__ __forceinline__ void operator()(const f32x4 (&acc)[2][2][4][2], const Unit& u, int wr, int wc, int fr, int fq) const {
        const int row0 = u.pm * BM + wr * 64 + fr, col0 = u.pn * HALF + wc * 32 + 8 * fq;
#pragma unroll
        for (int ai = 0; ai < 2; ++ai)
#pragma unroll
            for (int m = 0; m < 4; ++m) { const int r = row0 + ai * HALF + m * 16; const float rs = row_rs(ssq, r);
                f32x4 g0 = acc[ai][0][m][0] * rs, g1 = acc[ai][0][m][1] * rs, u0 = acc[ai][1][m][0] * rs, u1 = acc[ai][1][m][1] * rs;
#pragma unroll
                for (int e = 0; e < 4; ++e) { g0[e] = silu_f(g0[e]) * u0[e]; g1[e] = silu_f(g1[e]) * u1[e]; }
                u32x4 w; w.x = cvt_pk_bf16(g0[0], g0[1]); w.y = cvt_pk_bf16(g0[2], g0[3]); w.z = cvt_pk_bf16(g1[0], g1[1]); w.w = cvt_pk_bf16(g1[2], g1[3]);
                *(u32x4*)(hid + (size_t)r * 2816 + col0) = w; }
    }
};

struct EpiRes {
    static constexpr bool PERM = false, AFTER_DRAIN = true;
    const float* base; float* out; bf16_t* hb; float* ssq;
    __device__ __forceinline__ void fused(f32x4 (&acc)[2][2][4][2], const Unit& u, int wr, int wc, int fr, int fq, PG8_LAS unsigned char* lds, int wid, int lane) const {
        PG8_LAS float* P = (PG8_LAS float*)lds;
        const int col0 = u.pn * BM + wc * 32 + 4 * fq;
#pragma unroll
        for (int ai = 0; ai < 2; ++ai)
#pragma unroll
            for (int m = 0; m < 4; ++m) { const int rl = ai * HALF + wr * 64 + m * 16 + fr; const size_t off = (size_t)(u.pm * BM + rl) * 1024 + col0; float s = 0.f;
#pragma unroll
                for (int bj = 0; bj < 2; ++bj)
#pragma unroll
                    for (int n = 0; n < 2; ++n) { const f32x4 b = *(const f32x4*)(base + off + bj * HALF + n * 16); const f32x4 o = b + acc[ai][bj][m][n];
                        *(f32x4*)(out + off + bj * HALF + n * 16) = o; u32x2 w; w.x = cvt_pk_bf16(o[0], o[1]); w.y = cvt_pk_bf16(o[2], o[3]);
                        *(u32x2*)(hb + off + bj * HALF + n * 16) = w; s += (o[0] * o[0] + o[1] * o[1]) + (o[2] * o[2] + o[3] * o[3]); }
                s += __shfl_xor(s, 16); s += __shfl_xor(s, 32);
                if (fq == 0) P[rl * 4 + wc] = s;
                if (m & 1) asm volatile("" ::: "memory"); }
        asm volatile("s_waitcnt lgkmcnt(0)" ::: "memory"); __builtin_amdgcn_s_barrier(); asm volatile("" ::: "memory");
        const int tid = wid * 64 + lane;
        if (tid < 256) { const float t = (P[tid * 4 + 0] + P[tid * 4 + 1]) + (P[tid * 4 + 2] + P[tid * 4 + 3]); ssq[(size_t)(u.pm * BM + tid) * 4 + u.pn] = t; }
        asm volatile("s_waitcnt lgkmcnt(0)" ::: "memory"); __builtin_amdgcn_s_barrier(); asm volatile("" ::: "memory");
    }
};

template <class Epi, class Sched, bool ALIGN_EPI = false, bool SP2 = false>
__device__ __forceinline__ void gemm_phase(PG8_LAS unsigned char* lds, const Gemm g, const Sched& S, const Epi& E, const int wave_id  ) {
    int tid_ = wave_id * 64 + (int)__builtin_amdgcn_mbcnt_hi(~0u, __builtin_amdgcn_mbcnt_lo(~0u, 0u)); asm volatile("" : "+v"(tid_));
    const int tid = tid_, wid = __builtin_amdgcn_readfirstlane(tid >> 6), lane = tid & 63, wr = wid >> 2, wc = wid & 3, fr = lane & 15, fq = lane >> 4;
    const int K = g.K, nt = K / BK;
    unsigned voffA[2], voffB[2];
#pragma unroll
    for (int i = 0; i < 2; ++i) { int R, C; stage_rc(tid * 16 + i * 8192, R, C); const int Rb = Epi::PERM ? ((R & ~31) + perm32(R & 31)) : R;
        voffA[i] = (unsigned)(R * K + C) * 2u; voffB[i] = (unsigned)(Rb * K + C) * 2u; }
    const size_t kstep = (size_t)(BK * 2);
    const size_t hstep = (size_t)HALF * K * 2;
    const size_t tstep = 2 * hstep;
    const unsigned ldsw = (unsigned)wid * 1024u;
    const int aoff = lds_byte(wr * 64 + fr, fq * 8), boff = lds_byte(wc * 32 + fr, fq * 8);
#define PG8_SA(b, h) (((b) * 2 + (h)) * HTB)
#define PG8_SB(b, h) ((4 + (b) * 2 + (h)) * HTB)
#define PG8_STAGE(bufoff, gbase, voff) do { _Pragma("unroll") for (int _i = 0; _i < 2; ++_i) \
        __builtin_amdgcn_global_load_lds((const unsigned*)((const char*)(gbase) + (voff)[_i]), (PG8_LAS unsigned*)(lds + (bufoff) + ldsw + _i * 8192), 16, 0, 0); } while (0)
#define PG8_LDA(dst, b, h) do { _Pragma("unroll") for (int m = 0; m < 4; ++m) _Pragma("unroll") for (int k = 0; k < 2; ++k) dst[m][k] = *(const PG8_LAS bf16x8*)(lds + PG8_SA(b, h) + aoff + m * 2048 + k * 1024); } while (0)
#define PG8_LDB(dst, b, h) do { _Pragma("unroll") for (int n = 0; n < 2; ++n) _Pragma("unroll") for (int k = 0; k < 2; ++k) dst[n][k] = *(const PG8_LAS bf16x8*)(lds + PG8_SB(b, h) + boff + n * 2048 + k * 1024); } while (0)
#define PG8_MMA(ai, bj, At, Bt) do { __builtin_amdgcn_s_setprio(1); _Pragma("unroll") for (int m = 0; m < 4; ++m) _Pragma("unroll") for (int n = 0; n < 2; ++n) _Pragma("unroll") for (int k = 0; k < 2; ++k) \
        acc[ai][bj][m][n] = __builtin_amdgcn_mfma_f32_16x16x32_bf16(Bt[n][k], At[m][k], acc[ai][bj][m][n], 0, 0, 0); __builtin_amdgcn_s_setprio(0); } while (0)
#define PG8_WAIT_V(n) asm volatile("s_waitcnt vmcnt(" #n ")" ::: "memory")
#define PG8_WAIT_L(n) asm volatile("s_waitcnt lgkmcnt(" #n ")" ::: "memory")
#define PG8_BAR __builtin_amdgcn_s_barrier()
#define PG8_SCHED __builtin_amdgcn_sched_barrier(0)
    Unit cur, nxt; int ui = 0;
    if (!S.next(0, cur)) return;
    f32x4 acc[2][2][4][2];
#pragma unroll
    for (int a = 0; a < 2; ++a)
#pragma unroll
        for (int b = 0; b < 2; ++b)
#pragma unroll
            for (int m = 0; m < 4; ++m)
#pragma unroll
                for (int n = 0; n < 2; ++n) acc[a][b][m][n] = (f32x4){0.f, 0.f, 0.f, 0.f};
    bf16x8 At[4][2], B0[2][2], B1[2][2];
    const char* cA = (const char*)g.A + (size_t)cur.pm * tstep; const char* cB = (const char*)g.Bt + (size_t)cur.pn * tstep;
    S.a_ready(cur);
    if constexpr (SP2) {
        PG8_STAGE(PG8_SB(0, 0), cB, voffB); PG8_STAGE(PG8_SB(0, 1), cB + hstep, voffB); PG8_STAGE(PG8_SA(0, 0), cA, voffA); PG8_STAGE(PG8_SA(0, 1), cA + hstep, voffA);
        if (wr == 1) PG8_BAR;
        PG8_WAIT_V(2); PG8_BAR;
        PG8_STAGE(PG8_SB(1, 0), cB + kstep, voffB); PG8_STAGE(PG8_SA(1, 0), cA + kstep, voffA); PG8_STAGE(PG8_SB(1, 1), cB + hstep + kstep, voffB);
        PG8_WAIT_V(6); PG8_BAR;
    } else {
        PG8_STAGE(PG8_SB(0, 0), cB, voffB); PG8_STAGE(PG8_SA(0, 0), cA, voffA); PG8_STAGE(PG8_SB(0, 1), cB + hstep, voffB); PG8_STAGE(PG8_SA(0, 1), cA + hstep, voffA);
        if (wr == 1) PG8_BAR;
        PG8_WAIT_V(4); PG8_BAR;
        PG8_STAGE(PG8_SB(1, 0), cB + kstep, voffB); PG8_STAGE(PG8_SA(1, 0), cA + kstep, voffA); PG8_STAGE(PG8_SB(1, 1), cB + hstep + kstep, voffB);
        PG8_WAIT_V(6); PG8_BAR;
    }
    for (;;) {
        const bool has_next = S.next(ui + 1, nxt);
        const char* nA = has_next ? (const char*)g.A + (size_t)nxt.pm * tstep : cA; const char* nB = has_next ? (const char*)g.Bt + (size_t)nxt.pn * tstep : cB;
        for (int t = 0; t < nt; t += 2) {
            const bool last = (t == nt - 2);
            const char* a1 = cA + (size_t)(t + 1) * kstep;
            const char* a2 = last ? nA : cA + (size_t)(t + 2) * kstep; const char* b2 = last ? nB : cB + (size_t)(t + 2) * kstep;
            const char* a3 = a2 + kstep; const char* b3 = b2 + kstep;
            if (last && has_next) S.a_ready(nxt);
            if constexpr (SP2) {
            PG8_LDB(B0, 0, 0); PG8_LDB(B1, 0, 1); PG8_SCHED; PG8_LDA(At, 0, 0); PG8_STAGE(PG8_SA(1, 1), a1 + hstep, voffA);
            PG8_WAIT_V(8); PG8_WAIT_L(0); PG8_BAR; PG8_MMA(0, 0, At, B0); PG8_MMA(0, 1, At, B1); PG8_BAR; PG8_SCHED;
            PG8_LDA(At, 0, 1); PG8_STAGE(PG8_SB(0, 0), b2, voffB); PG8_STAGE(PG8_SB(0, 1), b2 + hstep, voffB); PG8_STAGE(PG8_SA(0, 0), a2, voffA);
            PG8_WAIT_V(8); PG8_WAIT_L(0); PG8_BAR; PG8_MMA(1, 0, At, B0); PG8_MMA(1, 1, At, B1); PG8_BAR; PG8_SCHED;
            PG8_LDB(B0, 1, 0); PG8_LDB(B1, 1, 1); PG8_SCHED; PG8_LDA(At, 1, 0); PG8_STAGE(PG8_SA(0, 1), a2 + hstep, voffA);
            PG8_WAIT_V(8); PG8_WAIT_L(0); PG8_BAR; PG8_MMA(0, 0, At, B0); PG8_MMA(0, 1, At, B1); PG8_BAR; PG8_SCHED;
            PG8_LDA(At, 1, 1); PG8_STAGE(PG8_SB(1, 0), b3, voffB); PG8_STAGE(PG8_SB(1, 1), b3 + hstep, voffB); PG8_STAGE(PG8_SA(1, 0), a3, voffA);
            PG8_WAIT_V(8); PG8_WAIT_L(0); PG8_BAR; PG8_MMA(1, 0, At, B0); PG8_MMA(1, 1, At, B1); PG8_BAR; PG8_SCHED;
            } else {
            PG8_LDB(B0, 0, 0); PG8_SCHED; PG8_LDA(At, 0, 0); PG8_STAGE(PG8_SA(1, 1), a1 + hstep, voffA);
            PG8_WAIT_L(8); PG8_BAR; PG8_WAIT_L(0); PG8_MMA(0, 0, At, B0); PG8_BAR; PG8_SCHED;
            PG8_LDB(B1, 0, 1); PG8_STAGE(PG8_SB(0, 0), b2, voffB);
            PG8_BAR; PG8_WAIT_L(0); PG8_MMA(0, 1, At, B1); PG8_BAR;
            PG8_LDA(At, 0, 1); PG8_STAGE(PG8_SA(0, 0), a2, voffA);
            PG8_BAR; PG8_WAIT_L(0); PG8_MMA(1, 0, At, B0); PG8_BAR; PG8_SCHED;
            PG8_STAGE(PG8_SB(0, 1), b2 + hstep, voffB);
            PG8_WAIT_V(6); PG8_BAR; PG8_MMA(1, 1, At, B1); PG8_BAR;
            PG8_LDB(B0, 1, 0); PG8_SCHED; PG8_LDA(At, 1, 0); PG8_STAGE(PG8_SA(0, 1), a2 + hstep, voffA);
            PG8_WAIT_L(8); PG8_BAR; PG8_WAIT_L(0); PG8_MMA(0, 0, At, B0); PG8_BAR; PG8_SCHED;
            PG8_LDB(B1, 1, 1); PG8_STAGE(PG8_SB(1, 0), b3, voffB);
            PG8_BAR; PG8_WAIT_L(0); PG8_MMA(0, 1, At, B1); PG8_BAR;
            PG8_LDA(At, 1, 1); PG8_STAGE(PG8_SA(1, 0), a3, voffA);
            PG8_BAR; PG8_WAIT_L(0); PG8_MMA(1, 0, At, B0); PG8_BAR; PG8_SCHED;
            PG8_STAGE(PG8_SB(1, 1), b3 + hstep, voffB);
            PG8_WAIT_V(6); PG8_BAR; PG8_MMA(1, 1, At, B1); PG8_BAR;
            }
        }
        if constexpr (ALIGN_EPI) { if (wr == 0) PG8_BAR; }
        if constexpr (!Epi::AFTER_DRAIN) { E(acc, cur, wr, wc, fr, fq); S.done(cur); }
        if (!has_next) break;
#pragma unroll
        for (int a = 0; a < 2; ++a)
#pragma unroll
            for (int b = 0; b < 2; ++b)
#pragma unroll
                for (int m = 0; m < 4; ++m)
#pragma unroll
                    for (int n = 0; n < 2; ++n) acc[a][b][m][n] = (f32x4){0.f, 0.f, 0.f, 0.f};
        cur = nxt; cA = nA; cB = nB; ++ui;
        if constexpr (ALIGN_EPI) { if (wr == 1) PG8_BAR; }
    }
    PG8_WAIT_V(0);
    if constexpr (!ALIGN_EPI) { if (wr == 0) PG8_BAR; }
    PG8_BAR;
    if constexpr (Epi::AFTER_DRAIN) { E.fused(acc, cur, wr, wc, fr, fq, lds, wid, lane); S.done(cur); }
#undef PG8_SA
#undef PG8_SB
#undef PG8_STAGE
#undef PG8_LDA
#undef PG8_LDB
#undef PG8_MMA
#undef PG8_WAIT_V
#undef PG8_WAIT_L
#undef PG8_BAR
#undef PG8_SCHED
}
}

constexpr int NWAVES = 8;
#ifndef MK_N_LAUNCHES
#define MK_N_LAUNCHES 1
#endif
constexpr int N_PHASES = 12;
constexpr int BATCH = 8, T = 2048, D = 1024, M = BATCH * T, DEPTH = 2;
constexpr int NPROJ = 3072, IN_DIM = 3080, QKV = 1536, DFF = 2816, NGU = 2 * DFF;
constexpr int NH = 4, DK = 128, CH = 64, NCH = T / CH;
constexpr int GMC = 128;
constexpr size_t WS_CTL = 0, CTL_BYTES = 1u << 20;
constexpr size_t SZ_WIN = (size_t)NPROJ * D * 2, SZ_WBA = 16 * D * 2, SZ_WOUT = (size_t)D * D * 2, SZ_WGU = (size_t)NGU * D * 2, SZ_WDN = (size_t)D * DFF * 2, SZ_WSB = 4 * 128 * 128 * 2;
constexpr size_t SZ_WL = SZ_WIN + SZ_WBA + SZ_WOUT + SZ_WGU + SZ_WDN + SZ_WSB;
constexpr size_t WS_W = WS_CTL + CTL_BYTES;
constexpr size_t OFF_WIN = 0, OFF_WBA = OFF_WIN + SZ_WIN, OFF_WOUT = OFF_WBA + SZ_WBA, OFF_WGU = OFF_WOUT + SZ_WOUT, OFF_WDN = OFF_WGU + SZ_WGU, OFF_WSB = OFF_WDN + SZ_WDN;
constexpr size_t WS_BG = WS_W + DEPTH * SZ_WL;
constexpr size_t WS_SSQ = WS_BG + (size_t)M * 8 * 4;
constexpr size_t WS_HB = WS_SSQ + (size_t)M * 4 * 4;
constexpr size_t WS_R = WS_HB + (size_t)M * D * 2;
constexpr size_t WS_QKV = WS_R;
constexpr size_t WS_OCAT = WS_QKV + (size_t)M * QKV * 2;
constexpr size_t WS_VG = WS_OCAT + (size_t)M * D * 2;
constexpr size_t WS_RING = WS_VG + (size_t)M * 512 * 2;
constexpr size_t WS_HID = WS_R;
constexpr int SL_WN = 0, SL_QG = 16384, SL_KGT = 32768, SL_QK = 49152, SL_UT = 57344, SL_MISC = 73728, SLOT_BYTES = 73984;
constexpr size_t WS_SSAVE = WS_RING + (size_t)32 * NCH * SLOT_BYTES;
constexpr size_t WS_END = WS_SSAVE + (size_t)32 * 512 * 128;
static_assert((size_t)M * DFF * 2 <= WS_RING - WS_R, "hidden overlay fits");
static_assert(WS_END <= 268435456ull, "d_ws map fits 256 MiB");
constexpr int CW_BAR = 4096;
constexpr int CW_FLAG = 16384;
static_assert((CW_FLAG + 2 * 32 * 32 * 16) * 4 <= (int)CTL_BYTES, "ctl words");
constexpr int RING_BYTES = 131072, LDS_BYTES = 147456, CTL_OFF = LDS_BYTES - 1024, MISC_OFF = CTL_OFF + 320;

#define GAS __attribute__((address_space(1)))
#define LAS __attribute__((address_space(3)))
typedef unsigned short bf16;
typedef unsigned v4u __attribute__((ext_vector_type(4)));
typedef unsigned v2u __attribute__((ext_vector_type(2)));
typedef float f32x4 __attribute__((ext_vector_type(4)));
typedef float f32x2 __attribute__((ext_vector_type(2)));
typedef short bf16x8 __attribute__((ext_vector_type(8)));
typedef short bf16x4 __attribute__((ext_vector_type(4)));
typedef GAS unsigned gu32;
#define RLX_AGENT __ATOMIC_RELAXED, __HIP_MEMORY_SCOPE_AGENT
#define LDS_WAIT() asm volatile("s_waitcnt lgkmcnt(0)" ::: "memory")
#define VM_WAIT() asm volatile("s_waitcnt vmcnt(0)" ::: "memory")
__device__ __forceinline__ unsigned pk2(float lo, float hi) { return pg8::cvt_pk_bf16(lo, hi); }
__device__ __forceinline__ float bf_lo(unsigned u) { return __uint_as_float(u << 16); }
__device__ __forceinline__ float bf_hi(unsigned u) { return __uint_as_float(u & 0xffff0000u); }
__device__ __forceinline__ float bf2f(unsigned short s) { return __uint_as_float((unsigned)s << 16); }
__device__ __forceinline__ float wave_sum(float v) {
#pragma unroll
    for (int o = 1; o < 64; o <<= 1) v += __shfl_xor(v, o);
    return v;
}
__device__ __forceinline__ bf16x8 mk8(v2u a, v2u b) { v4u t; t.x = a.x; t.y = a.y; t.z = b.x; t.w = b.y; return __builtin_bit_cast(bf16x8, t); }
__device__ __forceinline__ v2u pk4(f32x4 v) { v2u r; r.x = pk2(v[0], v[1]); r.y = pk2(v[2], v[3]); return r; }
__device__ __forceinline__ v2u pk4n(f32x4 v) { v2u r; r.x = pk2(-v[0], -v[1]); r.y = pk2(-v[2], -v[3]); return r; }
#define MFMA16(a, b, c) __builtin_amdgcn_mfma_f32_16x16x32_bf16((a), (b), (c), 0, 0, 0)
__device__ __forceinline__ int kperm(int c) { const int cc = c & 31; return (c & ~31) + 8 * ((cc & 15) >> 2) + 4 * (cc >> 4) + (cc & 3); }
__device__ __forceinline__ void st8_wt(__amdgpu_buffer_rsrc_t r, unsigned off, v2u v) { __builtin_amdgcn_raw_buffer_store_b64(v, r, (int)off, 0, 16); }
__device__ __forceinline__ void st16_wt(__amdgpu_buffer_rsrc_t r, unsigned off, v4u v) { __builtin_amdgcn_raw_buffer_store_b128(v, r, (int)off, 0, 16); }

#define XB_TMO      128
#define XB_XCNT(j)  (256  + 64 * (j))
#define XB_XSUB(j)  (1280 + 64 * (j))
#define XB_XGEN(j)  (2304 + 64 * (j))
#define XB_TOP      3328
#define XB_TOPGEN   3392
#define XCD_BAR_WORDS 3456
#define XB_SPIN_CAP (1u << 18)
__device__ __forceinline__ unsigned xb_ld(unsigned* p)              { return __hip_atomic_load(p, __ATOMIC_RELAXED, __HIP_MEMORY_SCOPE_AGENT); }
__device__ __forceinline__ unsigned xb_add(unsigned* p, unsigned v) { return __hip_atomic_fetch_add(p, v, __ATOMIC_RELAXED, __HIP_MEMORY_SCOPE_AGENT); }
__device__ __forceinline__ unsigned xb_xcc_id() { return (unsigned)__builtin_amdgcn_s_getreg((3 << 11) | 20) & 0xFu; }
#define XB_SPIN(cond, bar) do { unsigned _sp = 0; while (cond) { __builtin_amdgcn_s_sleep(1); \
    if ((++_sp & 255u) == 0u) { if (xb_ld(&(bar)[XB_TMO])) break; if (_sp > XB_SPIN_CAP) { atomicAdd(&(bar)[XB_TMO], 1u); break; } } } } while (0)
struct XcdBarrier { unsigned* bar; unsigned x; volatile LAS unsigned* st; };
__device__ __forceinline__ XcdBarrier xcd_barrier_post(unsigned* bar, volatile LAS unsigned* st) {
    XcdBarrier b; b.bar = bar; b.x = xb_xcc_id(); b.st = st;
    if (threadIdx.x == 0) (void)xb_add(&bar[XB_XCNT(b.x)], 1u);
    return b;
}
__device__ __forceinline__ void xcd_barrier_complete(unsigned* bar, unsigned x, unsigned& nloc, unsigned& nx) {
    const unsigned G = gridDim.x * gridDim.y * gridDim.z;
    unsigned sum, cnt, mine, sp = 0u;
    for (;;) {
        sum = 0u; cnt = 0u; mine = 0u;
#pragma unroll
        for (unsigned j = 0; j < 16; ++j) { const unsigned c = xb_ld(&bar[XB_XCNT(j)]); sum += c; cnt += (c > 0u) ? 1u : 0u; mine = (j == x) ? c : mine; }
        if (sum == G) break;
        __builtin_amdgcn_s_sleep(1);
        if ((++sp & 255u) == 0u) { if (xb_ld(&bar[XB_TMO])) break; if (sp > XB_SPIN_CAP) { atomicAdd(&bar[XB_TMO], 1u); break; } }
    }
    nloc = mine > 0u ? mine : 1u; nx = cnt > 0u ? cnt : 1u;
}
__device__ __forceinline__ void xcd_barrier(const XcdBarrier& b, const int wave_id) {
    asm volatile("s_waitcnt vmcnt(0)" ::: "memory");
    __syncthreads();
    if (wave_id == 0 && __builtin_amdgcn_mbcnt_hi(~0u, __builtin_amdgcn_mbcnt_lo(~0u, 0u)) == 0u) {
        unsigned* bar = b.bar;
        __builtin_amdgcn_s_waitcnt(0);
        unsigned nloc = b.st[0], nx = b.st[1];
        if (nloc == 0u) { xcd_barrier_complete(bar, b.x, nloc, nx); b.st[0] = nloc; b.st[1] = nx; }
        const unsigned old = xb_add(&bar[XB_XSUB(b.x)], 1u);
        const unsigned gen = old / nloc;
        if (old + 1u == (gen + 1u) * nloc) {
            __builtin_amdgcn_fence(__ATOMIC_RELEASE, "agent");
            asm volatile("s_waitcnt vmcnt(0)" ::: "memory");
            const unsigned og = xb_add(&bar[XB_TOP], 1u);
            const unsigned tg = og / nx;
            if (og + 1u == (tg + 1u) * nx) xb_add(&bar[XB_TOPGEN], 1u);
            else XB_SPIN(xb_ld(&bar[XB_TOPGEN]) == tg, bar);
            __builtin_amdgcn_fence(__ATOMIC_ACQUIRE, "agent");
            xb_add(&bar[XB_XGEN(b.x)], 1u);
            asm volatile("s_waitcnt vmcnt(0)" ::: "memory");
        } else {
            XB_SPIN(xb_ld(&bar[XB_XGEN(b.x)]) == gen, bar);
            __builtin_amdgcn_fence(__ATOMIC_ACQUIRE, "agent");
            asm volatile("s_waitcnt vmcnt(0)" ::: "memory");
        }
    }
    __syncthreads();
}

struct Args { const float* in[17]; float* out; unsigned char* ws; int ph_lo, ph_hi; };
#define CAS __attribute__((address_space(4)))
struct Frame {
    LAS unsigned char* lds;
    int tid, lane, wave, G, vcu;
    const CAS Args* A;
};
struct LayerW { bf16 *win, *wba, *wout, *wgu, *wdn, *wsb; };
__device__ __forceinline__ LayerW layer_w(unsigned char* ws, int l) {
    unsigned char* b = ws + WS_W + (size_t)l * SZ_WL; LayerW w;
    w.win = (bf16*)(b + OFF_WIN); w.wba = (bf16*)(b + OFF_WBA); w.wout = (bf16*)(b + OFF_WOUT); w.wgu = (bf16*)(b + OFF_WGU); w.wdn = (bf16*)(b + OFF_WDN); w.wsb = (bf16*)(b + OFF_WSB);
    return w;
}

__device__ __forceinline__ void p0_transpose_item(const float* W, int K, int N, int k0, int nsrc0, bf16* WT, int drow0, const float* scale, LAS float* scr, int lane) {
#pragma unroll 8
    for (int i = 0; i < 32; ++i) { const int kk = 2 * i + (lane >> 5); float v = W[(size_t)(k0 + kk) * N + nsrc0 + (lane & 31)]; if (scale) v *= scale[k0 + kk]; scr[kk * 33 + (lane & 31)] = v; }
    LDS_WAIT(); asm volatile("" ::: "memory");
    const int c = lane & 7;
#pragma unroll
    for (int j = 0; j < 4; ++j) { const int n = (lane >> 3) + 8 * j; const LAS float* s = scr + (8 * c) * 33 + n;
        v4u o; o.x = pk2(s[0 * 33], s[1 * 33]); o.y = pk2(s[2 * 33], s[3 * 33]); o.z = pk2(s[4 * 33], s[5 * 33]); o.w = pk2(s[6 * 33], s[7 * 33]);
        *(GAS v4u*)(WT + (size_t)(drow0 + n) * K + k0 + 8 * c) = o; }
    LDS_WAIT(); asm volatile("" ::: "memory");
}
__device__ __forceinline__ void p0_weights(Frame& F, const bool late, const int gw, const int NGW) {
    LAS float* scr = (LAS float*)(F.lds + F.wave * 16384);
    constexpr int I_IN = (D / 64) * (NPROJ / 32), I_OUT = (D / 64) * (D / 32), I_GU = (D / 64) * (NGU / 32), I_DN = (DFF / 64) * (D / 32), I_L = I_IN + I_OUT + I_GU + I_DN;
    const int lo = late ? I_IN : 0, hi = late ? DEPTH * I_L : I_IN;
    for (int it = lo + gw; it < hi; it += NGW) {
        const int l = it / I_L; int r = it % I_L; const LayerW w = layer_w(F.A->ws, l);
        if (r < I_IN) { const int nb = r % (NPROJ / 32), kb = r / (NPROJ / 32); const int nd = nb * 32, ns = nd + (nd >= 2048 ? 8 : 0);
            p0_transpose_item(F.A->in[2] + (size_t)l * D * IN_DIM, D, IN_DIM, kb * 64, ns, w.win, nd, F.A->in[1] + l * D, scr, F.lane); continue; } r -= I_IN;
        if (r < I_OUT) { const int nb = r % (D / 32), kb = r / (D / 32);
            p0_transpose_item(F.A->in[11] + (size_t)l * D * D, D, D, kb * 64, nb * 32, w.wout, nb * 32, nullptr, scr, F.lane); continue; } r -= I_OUT;
        if (r < I_GU) { const int nb = r % (NGU / 32), kb = r / (NGU / 32); const int tile = nb >> 3, j = nb & 7;
            const float* src = (j < 4 ? F.A->in[13] : F.A->in[14]) + (size_t)l * D * DFF;
            p0_transpose_item(src, D, DFF, kb * 64, tile * 128 + (j & 3) * 32, w.wgu, nb * 32, F.A->in[12] + l * D, scr, F.lane); continue; } r -= I_GU;
        { const int nb = r % (D / 32), kb = r / (D / 32);
            p0_transpose_item(F.A->in[15] + (size_t)l * DFF * D, DFF, D, kb * 64, nb * 32, w.wdn, nb * 32, nullptr, scr, F.lane); }
    }
}
__device__ __forceinline__ void p0_prologue(Frame& F) {
    const int gw = F.vcu * NWAVES + F.wave, NGW = F.G * NWAVES;
    p0_weights(F, false, gw, NGW);
    const int gt = F.vcu * (NWAVES * 64) + F.tid, NGT = F.G * NWAVES * 64;
    for (int i = gt; i < DEPTH * 16 * D; i += NGT) { const int l = i / (16 * D), j = (i / D) & 15, k = i % D;
        const float v = j < 8 ? F.A->in[2][(size_t)l * D * IN_DIM + (size_t)k * IN_DIM + 2048 + j] * F.A->in[1][l * D + k] : 0.f;
        layer_w(F.A->ws, l).wba[j * D + k] = (bf16)(pk2(v, 0.f) & 0xffffu); }
    for (int i = gt; i < DEPTH * 4 * 128 * 128; i += NGT) { const int l = i / (4 * 128 * 128), e = i % (4 * 128 * 128), t = (e >> 7) & 127, s = e & 127;
        const float v = (t >= s) ? F.A->in[9][i] : 0.f; layer_w(F.A->ws, l).wsb[e] = (bf16)(pk2(v, 0.f) & 0xffffu); }
    bf16* hb = (bf16*)(F.A->ws + WS_HB); float* ssq = (float*)(F.A->ws + WS_SSQ);
    for (int m = gw; m < M; m += NGW) {
        const GAS f32x4* xr = (const GAS f32x4*)(F.A->in[0] + (size_t)m * D) + F.lane; f32x4 v[4]; float s = 0.f;
#pragma unroll
        for (int j = 0; j < 4; ++j) { v[j] = xr[64 * j]; s += (v[j].x * v[j].x + v[j].y * v[j].y) + (v[j].z * v[j].z + v[j].w * v[j].w); }
        s = wave_sum(s);
        GAS v2u* o8 = (GAS v2u*)(hb + (size_t)m * D) + F.lane;
#pragma unroll
        for (int j = 0; j < 4; ++j) { v2u o; o.x = pk2(v[j].x, v[j].y); o.y = pk2(v[j].z, v[j].w); o8[64 * j] = o; }
        if (F.lane == 0) *(GAS f32x4*)(ssq + (size_t)m * 4) = (f32x4){s, 0.f, 0.f, 0.f};
    }
}

__device__ __forceinline__ void ba_rows(Frame& F, int l, int row0) {
    const bf16* hb = (const bf16*)(F.A->ws + WS_HB); const bf16* wba = layer_w(F.A->ws, l).wba; const float* ssq = (const float*)(F.A->ws + WS_SSQ); float* bg = (float*)(F.A->ws + WS_BG);
    const int fr = F.lane & 15, fq = F.lane >> 4, w = F.wave;
    f32x4 acc[4];
#pragma unroll
    for (int m = 0; m < 4; ++m) acc[m] = (f32x4){0.f, 0.f, 0.f, 0.f};
#pragma unroll
    for (int ks = 0; ks < 4; ++ks) { const int k0 = 128 * w + 32 * ks + 8 * fq;
        const bf16x8 b = *(const GAS bf16x8*)(wba + (size_t)fr * D + k0);
#pragma unroll
        for (int m = 0; m < 4; ++m) { const bf16x8 a = *(const GAS bf16x8*)(hb + (size_t)(row0 + 16 * m + fr) * D + k0); acc[m] = MFMA16(a, b, acc[m]); } }
    LAS float* part = (LAS float*)F.lds;
#pragma unroll
    for (int m = 0; m < 4; ++m)
#pragma unroll
        for (int r = 0; r < 4; ++r) part[(w * 64 + 16 * m + 4 * fq + r) * 16 + fr] = acc[m][r];
    LDS_WAIT(); __syncthreads();
    { const int row = F.tid >> 3, j = F.tid & 7; float s = 0.f;
#pragma unroll
      for (int ww = 0; ww < 8; ++ww) s += part[(ww * 64 + row) * 16 + j];
      s *= pg8::row_rs(ssq, row0 + row);
      float o;
      if (j < 4) o = 1.0f / (1.0f + __expf(-s));
      else { const float z = s + F.A->in[5][l * 4 + (j - 4)]; const float sp = z > 20.f ? z : log1pf(__expf(z)); o = -__expf(F.A->in[4][l * 4 + (j - 4)]) * sp; }
      bg[(size_t)(row0 + row) * 8 + j] = o; }
    __syncthreads();
}

constexpr int PK_KB = 0, PK_QB = 17408, PK_VT = 34816, PK_KT = 69632, PK_AF = 104448, PK_TD = 121856, PK_GC = 124928, PK_QKT = 132096;
constexpr int SC_W = 0, SC_Q = 18432, SC_K = 36864, SC_QK = 57344, SC_O = 67584, SC_OSZ = 33792, SC_OG = SC_O + 2 * SC_OSZ;

__device__ __forceinline__ void delta_prep_item(Frame& F, int l, int b, int h, int n, unsigned char* slot, gu32* flag) {
    const __amdgpu_buffer_rsrc_t srs = __builtin_amdgcn_make_buffer_rsrc(slot, 0, SLOT_BYTES, 0x00020000);
    const bf16* qkv = (const bf16*)(F.A->ws + WS_QKV); const float* bg = (const float*)(F.A->ws + WS_BG); const float* convw = F.A->in[3] + (size_t)l * 4 * QKV;
    LAS unsigned char* L = F.lds; int lane_ = F.lane; asm volatile("" : "+v"(lane_));
    const int lane = lane_, w = F.wave, tid = w * 64 + lane, fr = lane & 15, fq = lane >> 4;
    const int t0 = n * CH, R0 = b * T + t0;
    float gc, bval;
    { const float gv = bg[(size_t)(R0 + lane) * 8 + 4 + h]; bval = bg[(size_t)(R0 + lane) * 8 + h]; gc = gv;
#pragma unroll
      for (int o = 1; o < 64; o <<= 1) { const float t = __shfl_up(gc, o); if (lane >= o) gc += t; } }
    const float glast = __shfl(gc, 63);
    if (w == 0) { ((LAS float*)(L + PK_GC))[lane] = gc; ((LAS float*)(L + PK_GC))[64 + lane] = bval; }
    float eg[8], ek[8], be[8];
#pragma unroll
    for (int i = 0; i < 8; ++i) { const float g_i = __shfl(gc, 8 * w + i); eg[i] = __expf(g_i); ek[i] = __expf(glast - g_i); be[i] = __shfl(bval, 8 * w + i); }
#ifndef SK_A
    const int ch = 2 * lane;
#pragma unroll 1
    for (int X = 0; X < 3; ++X) { const int XX = (X == 0) ? 1 : (X == 1 ? 0 : 2);
        const int colx = XX * 512 + h * 128 + ch;
        float cw0[4], cw1[4];
#pragma unroll
        for (int j = 0; j < 4; ++j) { const f32x2 c2 = *(const GAS f32x2*)(convw + (size_t)j * QKV + colx); cw0[j] = c2.x; cw1[j] = c2.y; }
        float x0[11], x1[11];
#pragma unroll
        for (int rr = 0; rr < 11; ++rr) { const int tt = t0 + 8 * w + rr - 3; unsigned u = 0u; if (tt >= 0) u = *(const GAS unsigned*)(qkv + (size_t)(R0 + 8 * w + rr - 3) * QKV + colx); x0[rr] = bf_lo(u); x1[rr] = bf_hi(u); }
        float y0[8], y1[8];
#pragma unroll
        for (int i = 0; i < 8; ++i) { float a0 = 0.f, a1 = 0.f;
#pragma unroll
            for (int j = 0; j < 4; ++j) { a0 += cw0[j] * x0[i + j]; a1 += cw1[j] * x1[i + j]; }
            y0[i] = pg8::silu_f(a0); y1[i] = pg8::silu_f(a1); }
        if (XX < 2) {
#pragma unroll
            for (int i = 0; i < 8; ++i) { const float sq = wave_sum(y0[i] * y0[i] + y1[i] * y1[i]); const float rn = (XX == 0 ? 0.08838834764831845f : 1.0f) / sqrtf(sq + 1e-6f); y0[i] *= rn; y1[i] *= rn; } }
        if (XX == 0) {
#pragma unroll
            for (int i = 0; i < 8; ++i) { const int c = 8 * w + i;
                *(LAS unsigned*)(L + PK_QB + c * 272 + ch * 2) = pk2(y0[i], y1[i]); }
        } else if (XX == 1) {
#pragma unroll
            for (int i = 0; i < 8; ++i) { const int c = 8 * w + i; *(LAS unsigned*)(L + PK_KB + c * 272 + ch * 2) = pk2(y0[i], y1[i]); }
            { const int pa = kperm(8 * w), pb = kperm(8 * w + 4);
              st8_wt(srs, SL_KGT + ((ch) * 64 + pa) * 2, (v2u){pk2(y0[0] * ek[0], y0[1] * ek[1]), pk2(y0[2] * ek[2], y0[3] * ek[3])});
              st8_wt(srs, SL_KGT + ((ch) * 64 + pb) * 2, (v2u){pk2(y0[4] * ek[4], y0[5] * ek[5]), pk2(y0[6] * ek[6], y0[7] * ek[7])});
              st8_wt(srs, SL_KGT + ((ch + 1) * 64 + pa) * 2, (v2u){pk2(y1[0] * ek[0], y1[1] * ek[1]), pk2(y1[2] * ek[2], y1[3] * ek[3])});
              st8_wt(srs, SL_KGT + ((ch + 1) * 64 + pb) * 2, (v2u){pk2(y1[4] * ek[4], y1[5] * ek[5]), pk2(y1[6] * ek[6], y1[7] * ek[7])}); }
            LAS float* kt = (LAS float*)(L + PK_KT + ch * 272 + 8 * w * 4);
            *(LAS f32x4*)kt = (f32x4){y0[0] * be[0] * eg[0], y0[1] * be[1] * eg[1], y0[2] * be[2] * eg[2], y0[3] * be[3] * eg[3]};
            *(LAS f32x4*)(kt + 4) = (f32x4){y0[4] * be[4] * eg[4], y0[5] * be[5] * eg[5], y0[6] * be[6] * eg[6], y0[7] * be[7] * eg[7]};
            *(LAS f32x4*)(kt + 68) = (f32x4){y1[0] * be[0] * eg[0], y1[1] * be[1] * eg[1], y1[2] * be[2] * eg[2], y1[3] * be[3] * eg[3]};
            *(LAS f32x4*)(kt + 72) = (f32x4){y1[4] * be[4] * eg[4], y1[5] * be[5] * eg[5], y1[6] * be[6] * eg[6], y1[7] * be[7] * eg[7]};
        } else {
            LAS float* vt = (LAS float*)(L + PK_VT + ch * 272 + 8 * w * 4);
            *(LAS f32x4*)vt = (f32x4){y0[0] * be[0], y0[1] * be[1], y0[2] * be[2], y0[3] * be[3]};
            *(LAS f32x4*)(vt + 4) = (f32x4){y0[4] * be[4], y0[5] * be[5], y0[6] * be[6], y0[7] * be[7]};
            *(LAS f32x4*)(vt + 68) = (f32x4){y1[0] * be[0], y1[1] * be[1], y1[2] * be[2], y1[3] * be[3]};
            *(LAS f32x4*)(vt + 72) = (f32x4){y1[4] * be[4], y1[5] * be[5], y1[6] * be[6], y1[7] * be[7]};
        }
        asm volatile("" ::: "memory");
    }
#endif
    if (tid == 0) st16_wt(srs, SL_MISC, (v4u){__float_as_uint(__expf(glast)), 0u, 0u, 0u});
    LDS_WAIT(); __syncthreads();
    const LAS float* GC = (const LAS float*)(L + PK_GC); const LAS float* BE = GC + 64;
#ifndef SK_B1
    for (int fi = w; fi < 10; fi += 8) { const int mb = fi >= 6 ? 3 : (fi >= 3 ? 2 : (fi >= 1 ? 1 : 0)), sb = fi - (mb * (mb + 1)) / 2;
        f32x4 acc = (f32x4){0.f, 0.f, 0.f, 0.f};
#pragma unroll
        for (int ks = 0; ks < 4; ++ks) { const bf16x8 a = *(const LAS bf16x8*)(L + PK_KB + (16 * mb + fr) * 272 + (32 * ks + 8 * fq) * 2); const bf16x8 bb = *(const LAS bf16x8*)(L + PK_KB + (16 * sb + fr) * 272 + (32 * ks + 8 * fq) * 2); acc = MFMA16(a, bb, acc); }
        const int s = 16 * sb + fr; const float gs = GC[s];
#pragma unroll
        for (int r = 0; r < 4; ++r) { const int c = 16 * mb + 4 * fq + r; const float v = (c > s) ? acc[r] * BE[c] * __expf(fminf(GC[c] - gs, 0.f)) : 0.f; ((LAS float*)(L + PK_AF))[c * 68 + s] = v; } }
#endif
    LDS_WAIT(); __syncthreads();
#ifndef SK_C
    if (w < 4) { const int cc = fr; float t[16];
#pragma unroll
        for (int j = 0; j < 16; ++j) t[j] = (j == cc) ? 1.f : 0.f;
#pragma unroll
        for (int r = 1; r < 16; ++r) { const LAS f32x4* arow = (const LAS f32x4*)((const LAS float*)(L + PK_AF) + (16 * w + r) * 68 + 16 * w); float a = t[r];
            f32x4 av[4];
#pragma unroll
            for (int j4 = 0; j4 < 4; ++j4) if (4 * j4 < r) av[j4] = arow[j4];
#pragma unroll
            for (int j = 0; j < r; ++j) a -= av[j >> 2][j & 3] * t[j];
            t[r] = a; asm volatile("" ::: "memory"); }
        if (lane < 16) {
#pragma unroll
            for (int r = 0; r < 16; ++r) *(LAS unsigned short*)(L + PK_TD + (16 * w + r) * 48 + cc * 2) = (unsigned short)(pk2(r == cc ? 0.f : t[r], 0.f) & 0xffffu); }
    } else { const int mb = w - 4; const int c = 16 * mb + fr; const float gcc = GC[c];
#pragma unroll 1
        for (int sb = 0; sb < 4; ++sb) { v2u o; o.x = 0u; o.y = 0u;
            if (sb <= mb) { f32x4 acc = (f32x4){0.f, 0.f, 0.f, 0.f};
#pragma unroll
                for (int ks = 0; ks < 4; ++ks) { const bf16x8 kf = *(const LAS bf16x8*)(L + PK_KB + (16 * sb + fr) * 272 + (32 * ks + 8 * fq) * 2); const bf16x8 qf = *(const LAS bf16x8*)(L + PK_QB + (16 * mb + fr) * 272 + (32 * ks + 8 * fq) * 2); acc = MFMA16(kf, qf, acc); }
                f32x4 v;
#pragma unroll
                for (int r = 0; r < 4; ++r) { const int s = 16 * sb + 4 * fq + r; v[r] = (c >= s) ? acc[r] * __expf(fminf(gcc - GC[s], 0.f)) : 0.f; }
                o = pk4(v); }
            *(LAS v2u*)(L + PK_QKT + c * 144 + (32 * (sb >> 1) + 8 * fq + 4 * (sb & 1)) * 2) = o; } }
#endif
    LDS_WAIT(); __syncthreads();
#ifndef SK_D
    {
        const LAS float* AF = (const LAS float*)(L + PK_AF);
        const v2u z2 = (v2u){0u, 0u};
        bf16x8 td[4];
#pragma unroll
        for (int bb = 0; bb < 4; ++bb) td[bb] = mk8(*(const LAS v2u*)(L + PK_TD + (16 * bb + fr) * 48 + 4 * fq * 2), z2);
        const bf16x8 a10 = mk8(pk4n(*(const LAS f32x4*)(AF + (16 + fr) * 68 + 4 * fq)), z2);
        const bf16x8 a2x = mk8(pk4n(*(const LAS f32x4*)(AF + (32 + fr) * 68 + 4 * fq)), pk4n(*(const LAS f32x4*)(AF + (32 + fr) * 68 + 16 + 4 * fq)));
        const bf16x8 a3a = mk8(pk4n(*(const LAS f32x4*)(AF + (48 + fr) * 68 + 4 * fq)), pk4n(*(const LAS f32x4*)(AF + (48 + fr) * 68 + 16 + 4 * fq)));
        const bf16x8 a3b = mk8(pk4n(*(const LAS f32x4*)(AF + (48 + fr) * 68 + 32 + 4 * fq)), z2);
#pragma unroll
        for (int f = 0; f < 2; ++f) { const int n0 = 32 * w + 16 * f; const bool isU = n0 < 128; const int col = (n0 & 127) + fr;
            const LAS float* img = (const LAS float*)(L + (isU ? PK_VT : PK_KT) + col * 272);
            f32x4 X0 = *(const LAS f32x4*)(img + 4 * fq), X1 = *(const LAS f32x4*)(img + 16 + 4 * fq), X2 = *(const LAS f32x4*)(img + 32 + 4 * fq), X3 = *(const LAS f32x4*)(img + 48 + 4 * fq);
            X0 = MFMA16(td[0], mk8(pk4(X0), z2), X0);
            X1 = MFMA16(a10, mk8(pk4(X0), z2), X1); X1 = MFMA16(td[1], mk8(pk4(X1), z2), X1);
            const bf16x8 x01 = mk8(pk4(X0), pk4(X1));
            X2 = MFMA16(a2x, x01, X2); X2 = MFMA16(td[2], mk8(pk4(X2), z2), X2);
            X3 = MFMA16(a3a, x01, X3); X3 = MFMA16(a3b, mk8(pk4(X2), z2), X3); X3 = MFMA16(td[3], mk8(pk4(X3), z2), X3);
            if (isU) { LAS unsigned char* up = L + PK_VT + col * 272 + 4 * fq * 2;
                *(LAS v2u*)(up) = pk4(X0); *(LAS v2u*)(up + 32) = pk4(X1); *(LAS v2u*)(up + 64) = pk4(X2); *(LAS v2u*)(up + 96) = pk4(X3); }
            else { LAS unsigned char* wp = L + PK_KB + (4 * fq) * 272 + kperm(col) * 2;
#pragma unroll
                for (int r = 0; r < 4; ++r) { *(LAS unsigned short*)(wp + (r) * 272) = (unsigned short)(pk2(-X0[r], 0.f) & 0xffffu); *(LAS unsigned short*)(wp + (16 + r) * 272) = (unsigned short)(pk2(-X1[r], 0.f) & 0xffffu);
                    *(LAS unsigned short*)(wp + (32 + r) * 272) = (unsigned short)(pk2(-X2[r], 0.f) & 0xffffu); *(LAS unsigned short*)(wp + (48 + r) * 272) = (unsigned short)(pk2(-X3[r], 0.f) & 0xffffu); } }
        }
    }
#endif
    LDS_WAIT(); __syncthreads();
#pragma unroll
    for (int i = 0; i < 2; ++i) { const int idx = tid + 512 * i, row = idx >> 4, c16 = idx & 15;
        st16_wt(srs, SL_WN + row * 256 + c16 * 16, *(const LAS v4u*)(L + PK_KB + row * 272 + c16 * 16));
        const LAS unsigned char* qp = L + PK_QB + row * 272 + (32 * (c16 >> 2) + 4 * (c16 & 3)) * 2; const v2u qa = *(const LAS v2u*)qp, qb = *(const LAS v2u*)(qp + 32); const float e = __expf(GC[row]);
        st16_wt(srs, SL_QG + row * 256 + c16 * 16, (v4u){pk2(bf_lo(qa.x) * e, bf_hi(qa.x) * e), pk2(bf_lo(qa.y) * e, bf_hi(qa.y) * e), pk2(bf_lo(qb.x) * e, bf_hi(qb.x) * e), pk2(bf_lo(qb.y) * e, bf_hi(qb.y) * e)}); }
#pragma unroll
    for (int i = 0; i < 2; ++i) { const int idx = tid + 512 * i, row = idx >> 3, c16 = idx & 7; st16_wt(srs, SL_UT + row * 128 + c16 * 16, *(const LAS v4u*)(L + PK_VT + row * 272 + c16 * 16)); }
    { const int row = tid >> 3, c16 = tid & 7; st16_wt(srs, SL_QK + row * 128 + c16 * 16, *(const LAS v4u*)(L + PK_QKT + row * 144 + c16 * 16)); }
    asm volatile("s_waitcnt vmcnt(0)" ::: "memory");
    __syncthreads();
    if (tid == 0) __hip_atomic_store(flag, 1u, RLX_AGENT);
}

__device__ __forceinline__ void scan_spin(gu32* flag, gu32* tmo) {
    unsigned sp = 0;
    while ((unsigned)__builtin_amdgcn_readfirstlane(__hip_atomic_load(flag, RLX_AGENT)) == 0u) {
        __builtin_amdgcn_s_sleep(1);
        if ((++sp & 1023u) == 0u) { if (__hip_atomic_load(tmo, RLX_AGENT) != 0u) break; if (sp > (1u << 22)) { __hip_atomic_store(tmo, 1u, RLX_AGENT); break; } } }
}
#define AS_F4(x) __builtin_bit_cast(f32x4, (x))
#define AS_U4(x) __builtin_bit_cast(v4u, (x))
template <int BASE>
__device__ __forceinline__ void io_load(v4u (&R)[22], const unsigned char* slot, const bf16* zrow, int it) {
    const __amdgpu_buffer_rsrc_t r = __builtin_amdgcn_make_buffer_rsrc((void*)slot, 0, SLOT_BYTES, 0x00020000);
#pragma unroll
    for (int i = 0; i < 4; ++i) { const int idx = it + 256 * i;
        R[BASE + i] = __builtin_amdgcn_raw_buffer_load_b128(r, SL_WN + idx * 16, 0, 16); R[BASE + 4 + i] = __builtin_amdgcn_raw_buffer_load_b128(r, SL_QG + idx * 16, 0, 16); R[BASE + 8 + i] = __builtin_amdgcn_raw_buffer_load_b128(r, SL_KGT + idx * 16, 0, 16); }
#pragma unroll
    for (int i = 0; i < 2; ++i) R[BASE + 12 + i] = __builtin_amdgcn_raw_buffer_load_b128(r, SL_QK + (it + 256 * i) * 16, 0, 16);
#pragma unroll
    for (int i = 0; i < 4; ++i) R[BASE + 14 + i] = *(const GAS v4u*)(zrow + 8 * i);
}
template <int BASE>
__device__ __forceinline__ void io_stage(const v4u (&R)[22], LAS unsigned char* L, int it) {
#pragma unroll
    for (int i = 0; i < 4; ++i) { const int idx = it + 256 * i;
        *(LAS v4u*)(L + SC_W + (idx >> 4) * 288 + (idx & 15) * 16) = R[BASE + i]; *(LAS v4u*)(L + SC_Q + (idx >> 4) * 288 + (idx & 15) * 16) = R[BASE + 4 + i];
        *(LAS v4u*)(L + SC_K + (idx >> 3) * 160 + (idx & 7) * 16) = R[BASE + 8 + i]; }
#pragma unroll
    for (int i = 0; i < 2; ++i) { const int idx = it + 256 * i; *(LAS v4u*)(L + SC_QK + (idx >> 3) * 160 + (idx & 7) * 16) = R[BASE + 12 + i]; }
}
template <bool WRITE>
__device__ __forceinline__ void io_finalize(LAS unsigned char* L, int otile, const v4u (&R)[22], bf16* zp, int it) {
    const int seg = it & 3, row = it >> 2; const LAS float* orow = (const LAS float*)(L + SC_O + otile * SC_OSZ) + row * 132 + 32 * seg; const LAS f32x4* og = (const LAS f32x4*)(L + SC_OG) + 8 * seg;
    f32x4 v[8]; float s = 0.f;
#pragma unroll
    for (int j = 0; j < 8; ++j) { v[j] = *(const LAS f32x4*)(orow + 4 * j); s += (v[j].x * v[j].x + v[j].y * v[j].y) + (v[j].z * v[j].z + v[j].w * v[j].w); }
    s += __shfl_xor(s, 1); s += __shfl_xor(s, 2);
    const float rs = 1.0f / sqrtf(s * (1.0f / 128.0f) + 1e-6f);
#pragma unroll
    for (int i = 0; i < 4; ++i) { const v4u z = R[18 + i]; const unsigned zz[4] = {z.x, z.y, z.z, z.w}; unsigned oo[4];
#pragma unroll
        for (int j = 0; j < 4; ++j) { const f32x4 vv = v[2 * i + (j >> 1)], g4 = og[2 * i + (j >> 1)]; const int c0 = (2 * j) & 3; oo[j] = pk2(vv[c0] * rs * g4[c0] * bf_lo(zz[j]), vv[c0 + 1] * rs * g4[c0 + 1] * bf_hi(zz[j])); }
        if (WRITE) *(GAS v4u*)(zp + 8 * i) = (v4u){oo[0], oo[1], oo[2], oo[3]};
        else asm volatile("" :: "v"(oo[0]), "v"(oo[1]), "v"(oo[2]), "v"(oo[3])); }
}
template <bool WRITE, int BASE>
__device__ __forceinline__ void scan_step(Frame& F, int n, v4u (&R)[22], unsigned& fnext, gu32* flags, gu32* tmo, const unsigned char* slot0, bf16* ocat, int b, int h) {
    LAS unsigned char* L = F.lds; const int w = F.wave;
    int lane_ = F.lane; asm volatile("" : "+v"(lane_)); const int lane = lane_, fr = lane & 15, fq = lane >> 4, it = (w - 4) * 64 + lane;
    if (w >= 4) { io_stage<BASE>(R, L, it); if (n + 1 < NCH && w == 4 && fnext == 0u) scan_spin(flags + (n + 1) * 16, tmo); }
    LDS_WAIT(); __builtin_amdgcn_s_barrier(); asm volatile("" ::: "memory");
    if (w >= 4) {
        bf16* zrow = ocat + (size_t)(b * T + (it >> 2)) * D + h * 128 + 32 * (it & 3);
        v4u zc[4];
#pragma unroll
        for (int i = 0; i < 4; ++i) zc[i] = R[BASE + 14 + i];
        if (n + 1 < NCH) io_load<BASE>(R, slot0 + (size_t)(n + 1) * SLOT_BYTES, zrow + (size_t)(n + 1) * CH * D, it);
        if (w == 4 && n + 2 < NCH) fnext = __hip_atomic_load(flags + (n + 2) * 16, RLX_AGENT);
        if (n > 0) io_finalize<WRITE>(L, (n - 1) & 1, R, zrow + (size_t)(n - 1) * CH * D, it);
#pragma unroll
        for (int i = 0; i < 4; ++i) R[18 + i] = zc[i];
    } else {
        f32x4 vn[4][2], o[4][2];
#pragma unroll
        for (int m = 0; m < 4; ++m)
#pragma unroll
            for (int nf = 0; nf < 2; ++nf) { const v4u uu = R[16 + 2 * nf + (m >> 1)]; const unsigned ux = (m & 1) ? uu.z : uu.x, uy = (m & 1) ? uu.w : uu.y; vn[m][nf] = (f32x4){bf_lo(ux), bf_hi(ux), bf_lo(uy), bf_hi(uy)}; o[m][nf] = (f32x4){0.f, 0.f, 0.f, 0.f}; }
        const float dl = __uint_as_float(R[20].x);
        bf16x8 Sb[4][2];
#pragma unroll
        for (int ks = 0; ks < 4; ++ks)
#pragma unroll
            for (int nf = 0; nf < 2; ++nf) Sb[ks][nf] = mk8(pk4(AS_F4(R[2 * (2 * ks) + nf])), pk4(AS_F4(R[2 * (2 * ks + 1) + nf])));
        if (n + 1 < NCH) { const __amdgpu_buffer_rsrc_t r = __builtin_amdgcn_make_buffer_rsrc((void*)(slot0 + (size_t)(n + 1) * SLOT_BYTES), 0, SLOT_BYTES, 0x00020000);
#pragma unroll
            for (int nf = 0; nf < 2; ++nf)
#pragma unroll
                for (int mp = 0; mp < 2; ++mp) { const v2u u0 = __builtin_amdgcn_raw_buffer_load_b64(r, SL_UT + ((32 * w + 16 * nf + fr) * 64 + 16 * (2 * mp) + 4 * fq) * 2, 0, 16), u1 = __builtin_amdgcn_raw_buffer_load_b64(r, SL_UT + ((32 * w + 16 * nf + fr) * 64 + 16 * (2 * mp + 1) + 4 * fq) * 2, 0, 16);
                    R[16 + 2 * nf + mp] = (v4u){u0.x, u0.y, u1.x, u1.y}; }
            R[20].x = __builtin_amdgcn_raw_buffer_load_b32(r, SL_MISC, 0, 16); }
#define SB_() __builtin_amdgcn_sched_barrier(0)
#define LDF272(dst, base, m0) do { _Pragma("unroll") for (int ks = 0; ks < 4; ++ks) dst[ks] = *(const LAS bf16x8*)(L + (base) + (16 * (m0) + fr) * 288 + (32 * ks + 8 * fq) * 2); } while (0)
#define LDF144(dst, base, r0) do { _Pragma("unroll") for (int mm = 0; mm < 2; ++mm) _Pragma("unroll") for (int kc = 0; kc < 2; ++kc) dst[mm * 2 + kc] = *(const LAS bf16x8*)(L + (base) + (16 * ((r0) + mm) + fr) * 160 + (32 * kc + 8 * fq) * 2); } while (0)
#define MM4(acc, fr_) do { _Pragma("unroll") for (int ks = 0; ks < 4; ++ks) { acc[0] = MFMA16(fr_[ks], Sb[ks][0], acc[0]); acc[1] = MFMA16(fr_[ks], Sb[ks][1], acc[1]); } } while (0)
#define MM22(a0, a1, fr_) do { _Pragma("unroll") for (int kc = 0; kc < 2; ++kc) { a0[0] = MFMA16(fr_[kc], Vb[kc][0], a0[0]); a0[1] = MFMA16(fr_[kc], Vb[kc][1], a0[1]); a1[0] = MFMA16(fr_[2 + kc], Vb[kc][0], a1[0]); a1[1] = MFMA16(fr_[2 + kc], Vb[kc][1], a1[1]); } } while (0)
#define MMS(f0, fr_) do { _Pragma("unroll") for (int ff = 0; ff < 2; ++ff) _Pragma("unroll") for (int nf = 0; nf < 2; ++nf) { f32x4 a_ = AS_F4(R[2 * ((f0) + ff) + nf]) * dl; _Pragma("unroll") for (int kc = 0; kc < 2; ++kc) a_ = MFMA16(fr_[2 * ff + kc], Vb[kc][nf], a_); R[2 * ((f0) + ff) + nf] = AS_U4(a_); } } while (0)
        bf16x8 fa[4], fb[4];
        LDF272(fa, SC_W, 0); LDF272(fb, SC_W, 1); SB_();
        MM4(vn[0], fa); SB_(); LDF272(fa, SC_W, 2); SB_();
        MM4(vn[1], fb); SB_(); LDF272(fb, SC_W, 3); SB_();
        MM4(vn[2], fa); SB_(); LDF272(fa, SC_Q, 0); SB_();
        MM4(vn[3], fb); SB_(); LDF272(fb, SC_Q, 1); SB_();
        MM4(o[0], fa); SB_(); LDF272(fa, SC_Q, 2); SB_();
        MM4(o[1], fb); SB_(); LDF272(fb, SC_Q, 3); SB_();
        MM4(o[2], fa); SB_(); LDF144(fa, SC_QK, 0); SB_();
        MM4(o[3], fb); SB_(); LDF144(fb, SC_QK, 2);
        bf16x8 Vb[2][2];
#pragma unroll
        for (int kc = 0; kc < 2; ++kc)
#pragma unroll
            for (int nf = 0; nf < 2; ++nf) Vb[kc][nf] = mk8(pk4(vn[2 * kc][nf]), pk4(vn[2 * kc + 1][nf]));
        SB_();
        MM22(o[0], o[1], fa); SB_(); LDF144(fa, SC_K, 0); SB_();
        MM22(o[2], o[3], fb); SB_(); LDF144(fb, SC_K, 2); SB_();
        MMS(0, fa); SB_(); LDF144(fa, SC_K, 4); SB_();
        MMS(2, fb); SB_(); LDF144(fb, SC_K, 6); SB_();
        MMS(4, fa); SB_();
        MMS(6, fb); SB_();
#undef SB_
#undef LDF272
#undef LDF144
#undef MM4
#undef MM22
#undef MMS
        LAS float* ot = (LAS float*)(L + SC_O + (n & 1) * SC_OSZ);
#pragma unroll
        for (int m = 0; m < 4; ++m)
#pragma unroll
            for (int nf = 0; nf < 2; ++nf)
#pragma unroll
                for (int r = 0; r < 4; ++r) ot[(16 * m + 4 * fq + r) * 132 + 32 * w + 16 * nf + fr] = o[m][nf][r];
    }
    LDS_WAIT(); __builtin_amdgcn_s_barrier(); asm volatile("" ::: "memory");
}
template <bool WRITE>
__device__ __forceinline__ void delta_scan(Frame& F, int l, int bh) {
    const int b = bh >> 2, h = bh & 3; const int w = F.wave;
    bf16* ocat = (bf16*)(F.A->ws + WS_OCAT);
    gu32* flags = (gu32*)(F.A->ws + WS_CTL) + CW_FLAG + (size_t)((l * 32 + bh) * 32) * 16; gu32* tmo = (gu32*)(F.A->ws + WS_CTL) + CW_BAR + XB_TMO;
    const unsigned char* slot0 = F.A->ws + WS_RING + (size_t)(bh * NCH) * SLOT_BYTES;
    v4u R[22]; unsigned fnext = 0u;
#pragma unroll
    for (int i = 0; i < 22; ++i) R[i] = (v4u){0u, 0u, 0u, 0u};
    { int lane_ = F.lane; asm volatile("" : "+v"(lane_)); const int lane = lane_, tid = w * 64 + lane, fr = lane & 15, fq = lane >> 4, it = tid - 256;
      if (tid < 128) ((LAS float*)(F.lds + SC_OG))[tid] = F.A->in[6][l * 128 + tid];
      if (w == 4) scan_spin(flags, tmo);
      __syncthreads();
      if (w >= 4) { bf16* zrow = ocat + (size_t)(b * T + (it >> 2)) * D + h * 128 + 32 * (it & 3); io_load<0>(R, slot0, zrow, it); }
      else { const __amdgpu_buffer_rsrc_t r = __builtin_amdgcn_make_buffer_rsrc((void*)slot0, 0, SLOT_BYTES, 0x00020000);
#pragma unroll
          for (int nf = 0; nf < 2; ++nf)
#pragma unroll
              for (int mp = 0; mp < 2; ++mp) { const v2u u0 = __builtin_amdgcn_raw_buffer_load_b64(r, SL_UT + ((32 * w + 16 * nf + fr) * 64 + 16 * (2 * mp) + 4 * fq) * 2, 0, 16), u1 = __builtin_amdgcn_raw_buffer_load_b64(r, SL_UT + ((32 * w + 16 * nf + fr) * 64 + 16 * (2 * mp + 1) + 4 * fq) * 2, 0, 16);
                  R[16 + 2 * nf + mp] = (v4u){u0.x, u0.y, u1.x, u1.y}; }
          R[20].x = __builtin_amdgcn_raw_buffer_load_b32(r, SL_MISC, 0, 16); } }
#pragma unroll 1
    for (int n = 0; n < NCH; ++n) scan_step<WRITE, 0>(F, n, R, fnext, flags, tmo, slot0, ocat, b, h);
    { int lane_ = F.lane; asm volatile("" : "+v"(lane_)); const int it = (w - 4) * 64 + lane_;
      if (w >= 4) io_finalize<WRITE>(F.lds, (NCH - 1) & 1, R, ocat + (size_t)(b * T + (NCH - 1) * CH + (it >> 2)) * D + h * 128 + 32 * (it & 3), it); }
    __syncthreads();
}

__device__ __forceinline__ void gmlp_item(Frame& F, int l, int item) {
    const int g = item & 3, n = (item >> 2) & 15, b = item >> 6; const int R0 = b * T + n * GMC;
    const bf16* vg = (const bf16*)(F.A->ws + WS_VG); bf16* ocat = (bf16*)(F.A->ws + WS_OCAT); const bf16* wsb = layer_w(F.A->ws, l).wsb + (size_t)g * 128 * 128;
    const float* lng = F.A->in[7] + l * 512 + g * 128; const float* lnb = F.A->in[8] + l * 512 + g * 128; const float* bs = F.A->in[10] + (size_t)l * 512 + g * 128;
    LAS unsigned char* L = F.lds; int lane_ = F.lane; asm volatile("" : "+v"(lane_)); const int lane = lane_, w = F.wave, fr = lane & 15, fq = lane >> 4;
    { const int ch = 2 * lane; const float g0 = lng[ch], g1 = lng[ch + 1], b0 = lnb[ch], b1 = lnb[ch + 1]; float y0[16], y1[16];
#pragma unroll
      for (int i = 0; i < 16; ++i) { const unsigned u = *(const GAS unsigned*)(vg + (size_t)(R0 + 16 * w + i) * 512 + g * 128 + ch); const float a0 = bf_lo(u), a1 = bf_hi(u);
          const float mu = wave_sum(a0 + a1) * (1.0f / 128.0f); const float d0 = a0 - mu, d1 = a1 - mu; const float var = wave_sum(d0 * d0 + d1 * d1) * (1.0f / 128.0f); const float rs = 1.0f / sqrtf(var + 1e-6f);
          y0[i] = d0 * rs * g0 + b0; y1[i] = d1 * rs * g1 + b1; }
      *(LAS v4u*)(L + ch * 272 + 32 * w) = (v4u){pk2(y0[0], y0[1]), pk2(y0[2], y0[3]), pk2(y0[4], y0[5]), pk2(y0[6], y0[7])};
      *(LAS v4u*)(L + ch * 272 + 32 * w + 16) = (v4u){pk2(y0[8], y0[9]), pk2(y0[10], y0[11]), pk2(y0[12], y0[13]), pk2(y0[14], y0[15])};
      *(LAS v4u*)(L + (ch + 1) * 272 + 32 * w) = (v4u){pk2(y1[0], y1[1]), pk2(y1[2], y1[3]), pk2(y1[4], y1[5]), pk2(y1[6], y1[7])};
      *(LAS v4u*)(L + (ch + 1) * 272 + 32 * w + 16) = (v4u){pk2(y1[8], y1[9]), pk2(y1[10], y1[11]), pk2(y1[12], y1[13]), pk2(y1[14], y1[15])}; }
    LDS_WAIT(); __syncthreads();
    const int t = 16 * w + fr; const int nks = (16 * w + 15) / 32 + 1;
    bf16x8 wf[4];
#pragma unroll
    for (int ks = 0; ks < 4; ++ks) wf[ks] = (ks < nks) ? *(const GAS bf16x8*)(wsb + (size_t)t * 128 + 32 * ks + 8 * fq) : (bf16x8){0, 0, 0, 0, 0, 0, 0, 0};
    const float bst = bs[t];
#pragma unroll
    for (int nf = 0; nf < 8; ++nf) { f32x4 acc = (f32x4){0.f, 0.f, 0.f, 0.f};
#pragma unroll
        for (int ks = 0; ks < 4; ++ks) if (ks < nks) { const bf16x8 vf = *(const LAS bf16x8*)(L + (16 * nf + fr) * 272 + (32 * ks + 8 * fq) * 2); acc = MFMA16(vf, wf[ks], acc); }
        bf16* up = ocat + (size_t)(R0 + t) * D + 512 + g * 128 + 16 * nf + 4 * fq; const v2u u = *(const GAS v2u*)up;
        v2u o; o.x = pk2(bf_lo(u.x) * (acc[0] + bst), bf_hi(u.x) * (acc[1] + bst)); o.y = pk2(bf_lo(u.y) * (acc[2] + bst), bf_hi(u.y) * (acc[3] + bst));
        *(GAS v2u*)up = o; }
    __syncthreads();
}

__device__ __forceinline__ void final_norm(Frame& F) {
    const int gw = F.vcu * NWAVES + F.wave, NGW = F.G * NWAVES; const float* ssq = (const float*)(F.A->ws + WS_SSQ); const float* gn = F.A->in[16];
    f32x4 gv[4];
#pragma unroll
    for (int j = 0; j < 4; ++j) gv[j] = *(const GAS f32x4*)(gn + 4 * F.lane + 256 * j);
    for (int m = gw; m < M; m += NGW) { const float rs = pg8::row_rs(ssq, m); GAS f32x4* xr = (GAS f32x4*)(F.A->out + (size_t)m * D) + F.lane;
#pragma unroll
        for (int j = 0; j < 4; ++j) { f32x4 v = xr[64 * j]; v = v * rs * gv[j]; xr[64 * j] = v; } }
}

__global__ void __launch_bounds__(NWAVES * 64, 2) hyb_fwd(Args args) {
    extern __shared__ __attribute__((aligned(16))) unsigned char lds[];
    Frame F;
    F.lds = (LAS unsigned char*)lds;
    F.tid = threadIdx.x; F.lane = F.tid & 63; F.wave = __builtin_amdgcn_readfirstlane(F.tid >> 6);
    const int wave0 = F.wave;
    F.G = gridDim.x; { const int bx = blockIdx.x; F.vcu = (F.G % 8 == 0) ? (bx % 8) * (F.G / 8) + bx / 8 : bx; }
    F.A = (const CAS Args*)__builtin_amdgcn_kernarg_segment_ptr();
    gu32* ctl = (gu32*)(args.ws + WS_CTL);
    volatile LAS unsigned* MISC = (volatile LAS unsigned*)(F.lds + MISC_OFF);
    for (int u = F.tid; u < 1024 / 4; u += NWAVES * 64) ((LAS unsigned*)(F.lds + CTL_OFF))[u] = 0u;
    __syncthreads();
    const int lo = args.ph_lo, hi = args.ph_hi;
    const bool multi = (hi - lo) > 1;
    XcdBarrier bar; bar.bar = (unsigned*)(ctl + CW_BAR); bar.x = 0; bar.st = nullptr;
    if (multi) bar = xcd_barrier_post((unsigned*)(ctl + CW_BAR), MISC + 8);
#define RELAUNDER() do { int t_ = wave0 * 64 + (int)__builtin_amdgcn_mbcnt_hi(~0u, __builtin_amdgcn_mbcnt_lo(~0u, 0u)); asm volatile("" : "+v"(t_)); F.tid = t_; F.lane = t_ & 63; F.wave = wave0; const CAS Args* a_ = (const CAS Args*)__builtin_amdgcn_kernarg_segment_ptr(); asm volatile("" : "+s"(a_)); F.A = a_; } while (0)
#define IN(k) (lo <= (k) && (k) < hi)
#define SEAM(k) do { if (IN(k) && IN((k) + 1)) xcd_barrier(bar, wave0); } while (0)
#define WSP(off) (F.A->ws + (off))
#ifndef NO_P0
    if (IN(0)) { RELAUNDER(); p0_prologue(F); }
#endif
    SEAM(0);
#pragma unroll 1
    for (int l = 0; l < DEPTH; ++l) { const int pb = 1 + 5 * l;
        if (IN(pb)) {
            RELAUNDER();
#ifndef NO_G1
            { pg8::Gemm g{(bf16*)WSP(WS_HB), layer_w(F.A->ws, l).win, M, NPROJ, D}; pg8::StaticOrder S; S.init(M, NPROJ, F.G, (int)blockIdx.x);
              pg8::EpiProj E{(bf16*)WSP(WS_QKV), (bf16*)WSP(WS_OCAT), (bf16*)WSP(WS_VG), (const float*)WSP(WS_SSQ)};
              pg8::gemm_phase<pg8::EpiProj, pg8::StaticOrder, true, true>(F.lds, g, S, E, wave0);
#ifdef PROBE_G1X2
              pg8::gemm_phase<pg8::EpiProj, pg8::StaticOrder, true, true>(F.lds, g, S, E, wave0);
#endif
            }
#endif
#ifndef NO_BA
            RELAUNDER();
            for (int r0 = 64 * (int)blockIdx.x; r0 < M; r0 += 64 * F.G) ba_rows(F, l, r0);
#endif
        } SEAM(pb);
        if (IN(pb + 1)) {
            RELAUNDER();
            if ((int)blockIdx.x < 32) {
#ifndef NO_DELTA
#ifdef PROBE_SCAN2
                delta_scan<false>(F, l, (int)blockIdx.x);
#endif
                delta_scan<true>(F, l, (int)blockIdx.x);
#endif
            } else { const int p = (int)blockIdx.x - 32, np = F.G - 32;
#ifndef NO_DELTA
#pragma unroll 1
                for (int j = p; j < 32 * NCH; j += np) { const int bh = j & 31, n = j >> 5;
                    delta_prep_item(F, l, bh >> 2, bh & 3, n, F.A->ws + WS_RING + (size_t)(bh * NCH + n) * SLOT_BYTES, (gu32*)(F.A->ws + WS_CTL) + CW_FLAG + (size_t)((l * 32 + bh) * 32 + n) * 16); }
#endif
#ifndef NO_GMLP
#pragma unroll 1
                for (int it = p; it < 512; it += np) gmlp_item(F, l, it);
#endif
                if (l == 0) { __syncthreads(); p0_weights(F, true, p * NWAVES + F.wave, np * NWAVES); }
            }
        } SEAM(pb + 1);
        if (IN(pb + 2)) {
            RELAUNDER();
#ifndef NO_G2
            pg8::Gemm g{(bf16*)WSP(WS_OCAT), layer_w(F.A->ws, l).wout, M, D, D}; pg8::StaticOrder S; S.init(M, D, F.G, (int)blockIdx.x);
            pg8::EpiRes E{l == 0 ? F.A->in[0] : F.A->out, F.A->out, (bf16*)WSP(WS_HB), (float*)WSP(WS_SSQ)};
            pg8::gemm_phase<pg8::EpiRes, pg8::StaticOrder, false, true>(F.lds, g, S, E, wave0);
#endif
        } SEAM(pb + 2);
        if (IN(pb + 3)) {
            RELAUNDER();
#ifndef NO_G3
            pg8::Gemm g{(bf16*)WSP(WS_HB), layer_w(F.A->ws, l).wgu, M, NGU, D}; pg8::StaticOrder S; S.init(M, NGU, F.G, (int)blockIdx.x);
            pg8::EpiSwiglu E{(bf16*)WSP(WS_HID), (const float*)WSP(WS_SSQ)};
            pg8::gemm_phase<pg8::EpiSwiglu, pg8::StaticOrder, true, true>(F.lds, g, S, E, wave0);
#ifdef PROBE_G3X2
            pg8::gemm_phase<pg8::EpiSwiglu, pg8::StaticOrder, true, true>(F.lds, g, S, E, wave0);
#endif
#endif
        } SEAM(pb + 3);
        if (IN(pb + 4)) {
            RELAUNDER();
#ifndef NO_G4
            pg8::Gemm g{(bf16*)WSP(WS_HID), layer_w(F.A->ws, l).wdn, M, D, DFF}; pg8::StaticOrder S; S.init(M, D, F.G, (int)blockIdx.x);
            pg8::EpiRes E{F.A->out, F.A->out, (bf16*)WSP(WS_HB), (float*)WSP(WS_SSQ)};
            pg8::gemm_phase<pg8::EpiRes, pg8::StaticOrder, false, true>(F.lds, g, S, E, wave0);
#endif
        } SEAM(pb + 4);
    }
#ifndef NO_FN
    if (IN(11)) { RELAUNDER(); final_norm(F); }
#endif
#undef IN
#undef SEAM
}

extern "C" void kernel_launch(void* const* d_in, const int* in_sizes, int n_in, void* d_out, int out_size, void* d_ws, size_t ws_size, hipStream_t stream) {
    static int grid = 0;
    if (grid == 0) {
        if (n_in != 17 || in_sizes[0] != M * D || out_size != M * D || ws_size < WS_END) { fprintf(stderr, "kernel_launch: unexpected shapes (n_in %d, in0 %d, out %d, ws %zu < %zu)\n", n_in, n_in > 0 ? in_sizes[0] : -1, out_size, ws_size, (size_t)WS_END); grid = -1; return; }
        int dev = 0, cus = 0, per_cu = 0;
        if (hipGetDevice(&dev) != hipSuccess || hipDeviceGetAttribute(&cus, hipDeviceAttributeMultiprocessorCount, dev) != hipSuccess) { grid = -1; return; }
        if (hipFuncSetAttribute((const void*)hyb_fwd, hipFuncAttributeMaxDynamicSharedMemorySize, LDS_BYTES) != hipSuccess) { fprintf(stderr, "kernel_launch: hipFuncSetAttribute failed\n"); grid = -1; return; }
        if (hipOccupancyMaxActiveBlocksPerMultiprocessor(&per_cu, (const void*)hyb_fwd, NWAVES * 64, LDS_BYTES) != hipSuccess || per_cu < 1) { fprintf(stderr, "kernel_launch: occupancy query says %d blocks per CU\n", per_cu); per_cu = 1; }
        (void)hipGetLastError();
        grid = cus;
    }
    if (grid < 0) return;
    (void)hipMemsetAsync((char*)d_ws + WS_CTL, 0, CTL_BYTES, stream);
    Args a{};
    for (int i = 0; i < 17; ++i) a.in[i] = (const float*)d_in[i];
    a.out = (float*)d_out; a.ws = (unsigned char*)d_ws;
    if (MK_N_LAUNCHES == 1) {
        a.ph_lo = 0; a.ph_hi = N_PHASES;
        void* params[] = {&a};
        hipError_t e = hipLaunchCooperativeKernel((const void*)hyb_fwd, dim3(grid), dim3(NWAVES * 64), params, LDS_BYTES, stream);
        if (e != hipSuccess) fprintf(stderr, "kernel_launch: cooperative launch failed: %s (grid %d)\n", hipGetErrorString(e), grid);
    } else {
        for (int p = 0; p < N_PHASES; ++p) { a.ph_lo = p; a.ph_hi = p + 1; hipLaunchKernelGGL(hyb_fwd, dim3(grid), dim3(NWAVES * 64), LDS_BYTES, stream, a); }
    }
}
```

```cpp
#include <hip/hip_runtime.h>
#include <cstdio>
#include <cstdint>
namespace pg8 {
#define PG8_LAS __attribute__((address_space(3)))
typedef unsigned short bf16_t;
typedef short bf16x8 __attribute__((ext_vector_type(8)));
typedef float f32x4 __attribute__((ext_vector_type(4)));
typedef unsigned u32x4 __attribute__((ext_vector_type(4)));
constexpr int BM = 256, BK = 64, HALF = 128, HTB = HALF * BK * 2  , STAGE_BYTES = 8 * HTB, NXCD = 8, WGM = 8;

__host__ __device__ __forceinline__ int lds_byte(int r, int c) { const int st = (r >> 4) * 2 + (c >> 5), rr = r & 15, cc = c & 31, ob = rr * 64 + cc * 2; return st * 1024 + (ob ^ (((ob >> 9) & 1) << 5)); }
__host__ __device__ __forceinline__ void stage_rc(int b, int& R, int& C) { const int st = b / 1024, sb = b % 1024, swz = sb ^ (((sb >> 9) & 1) << 5); R = (st >> 1) * 16 + swz / 64; C = (st & 1) * 32 + (swz % 64) / 2; }
__host__ __device__ __forceinline__ int perm32(int rho) { const int n = rho >> 4, i = rho & 15; return 8 * (i >> 2) + 4 * n + (i & 3); }

struct Unit { int pm, pn; };
struct Gemm { const bf16_t* A; const bf16_t* Bt; int M, N, K; };

struct StaticOrder {
    int nM, nN, nwg, G, c;
    __host__ __device__ void init(int M, int N, int G_, int c_) { nM = M / BM; nN = N / BM; nwg = nM * nN; G = G_; c = c_; }
    __host__ __device__ bool next(int i, Unit& u) const {
        const long L = (long)i * G + c; if (L >= nwg) return false;
        int wgid = (int)L; { const int q = nwg / NXCD, r = nwg % NXCD, xcd = wgid % NXCD, off = wgid / NXCD; wgid = (xcd < r ? xcd * (q + 1) : r * (q + 1) + (xcd - r) * q) + off; }
        const int nig = WGM * nN, gid = wgid / nig, fm = gid * WGM, gsz = (nM - fm) < WGM ? (nM - fm) : WGM;
        u.pm = fm + ((wgid % nig) % gsz); u.pn = (wgid % nig) / gsz; return true;
    }
    __device__ __forceinline__ void a_ready(const Unit&) const {}
    __device__ __forceinline__ void done(const Unit&) const {}
};

typedef float f32x2_t __attribute__((ext_vector_type(2))); typedef __bf16 bf16x2_t __attribute__((ext_vector_type(2)));
__device__ __forceinline__ unsigned cvt_pk_bf16(float lo, float hi) { f32x2_t v = {lo, hi}; bf16x2_t b = __builtin_convertvector(v, bf16x2_t); return __builtin_bit_cast(unsigned, b); }
typedef float f32x2 __attribute__((ext_vector_type(2)));
typedef unsigned u32x2 __attribute__((ext_vector_type(2)));
constexpr float RMS_EPS = 1e-6f;
__device__ __forceinline__ float fast_sigmoid(float x) { return __builtin_amdgcn_rcpf(1.0f + __builtin_amdgcn_exp2f(-1.4426950408889634f * x)); }
__device__ __forceinline__ float silu_f(float x) { return x * fast_sigmoid(x); }
__device__ __forceinline__ float gelu_tanh_f(float x) { const float z = 1.5957691216057308f * (x + 0.044715f * x * x * x); return x * fast_sigmoid(z); }
__device__ __forceinline__ float row_rs(const float* ssq, int row) { const f32x4 s = *(const f32x4*)(ssq + (size_t)row * 4); return 1.0f / sqrtf(((s[0] + s[1]) + (s[2] + s[3])) * (1.0f / 1024.0f) + RMS_EPS); }

struct EpiProj {
    static constexpr bool PERM = true, AFTER_DRAIN = false;
    bf16_t* qkv; bf16_t* ocat; bf16_t* vg; const float* ssq;
    __device__ __forceinline__ void operator()(const f32x4 (&acc)[2][2][4][2], const Unit& u, int wr, int wc, int fr, int fq) const {
        const int pn = u.pn; bf16_t* base; int ldc, colt, act;
        if (pn < 6) { base = qkv; ldc = 1536; colt = 256 * pn; act = 0; }
        else if (pn < 8) { base = ocat; ldc = 1024; colt = 256 * (pn - 6); act = 1; }
        else if (pn < 10) { base = ocat; ldc = 1024; colt = 512 + 256 * (pn - 8); act = 2; }
        else { base = vg; ldc = 512; colt = 256 * (pn - 10); act = 2; }
        const int row0 = u.pm * BM + wr * 64 + fr, col0 = colt + wc * 32 + 8 * fq;
#pragma unroll
        for (int ai = 0; ai < 2; ++ai)
#pragma unroll
            for (int m = 0; m < 4; ++m) { const int r = row0 + ai * HALF + m * 16; const float rs = row_rs(ssq, r); bf16_t* rowp = base + (size_t)r * ldc + col0;
#pragma unroll
                for (int bj = 0; bj < 2; ++bj) { f32x4 v0 = acc[ai][bj][m][0] * rs, v1 = acc[ai][bj][m][1] * rs;
                    if (act == 1) {
#pragma unroll
                        for (int e = 0; e < 4; ++e) { v0[e] = silu_f(v0[e]); v1[e] = silu_f(v1[e]); } }
                    else if (act == 2) {
#pragma unroll
                        for (int e = 0; e < 4; ++e) { v0[e] = gelu_tanh_f(v0[e]); v1[e] = gelu_tanh_f(v1[e]); } }
                    u32x4 w; w.x = cvt_pk_bf16(v0[0], v0[1]); w.y = cvt_pk_bf16(v0[2], v0[3]); w.z = cvt_pk_bf16(v1[0], v1[1]); w.w = cvt_pk_bf16(v1[2], v1[3]);
                    *(u32x4*)(rowp + bj * HALF) = w; } }
    }
};

struct EpiSwiglu {
    static constexpr bool PERM = true, AFTER_DRAIN = false;
    bf16_t* hid; const float* ssq;
    __device__ __forceinline__ void operator()(const f32x4 (&acc)[2][2][4][2], const Unit& u, int wr, int wc, int fr, int fq) const {
        const int row0 = u.pm * BM + wr * 64 + fr, col0 = u.pn * HALF + wc * 32 + 8 * fq;
#pragma unroll
        for (int ai = 0; ai < 2; ++ai)
#pragma unroll
            for (int m = 0; m < 4; ++m) { const int r = row0 + ai * HALF + m * 16; const float rs = row_rs(ssq, r);
                f32x4 g0 = acc[ai][0][m][0] * rs, g1 = acc[ai][0][m][1] * rs, u0 = acc[ai][1][m][0] * rs, u1 = acc[ai][1][m][1] * rs;
#pragma unroll
                for (int e = 0; e < 4; ++e) { g0[e] = silu_f(g0[e]) * u0[e]; g1[e] = silu_f(g1[e]) * u1[e]; }
                u32x4 w; w.x = cvt_pk_bf16(g0[0], g0[1]); w.y = cvt_pk_bf16(g0[2], g0[3]); w.z = cvt_pk_bf16(g1[0], g1[1]); w.w = cvt_pk_bf16(g1[2], g1[3]);
                *(u32x4*)(hid + (size_t)r * 2816 + col0) = w; }
    }
};

struct EpiRes {
    static constexpr bool PERM = false, AFTER_DRAIN = true;
    bf16_t* hb; float* ssq;
    __device__ __forceinline__ void fused(f32x4 (&acc)[2][2][4][2], const Unit& u, int wr, int wc, int fr, int fq, PG8_LAS unsigned char* lds, int wid, int lane) const {
        PG8_LAS float* P = (PG8_LAS float*)lds;
        const int col0 = u.pn * BM + wc * 32 + 4 * fq;
#pragma unroll
        for (int ai = 0; ai < 2; ++ai)
#pragma unroll
            for (int m = 0; m < 4; ++m) { const int rl = ai * HALF + wr * 64 + m * 16 + fr; const size_t off = (size_t)(u.pm * BM + rl) * 1024 + col0; float s = 0.f;
                u32x2 b[2][2];
#pragma unroll
                for (int bj = 0; bj < 2; ++bj)
#pragma unroll
                    for (int n = 0; n < 2; ++n) b[bj][n] = *(const u32x2*)(hb + off + bj * HALF + n * 16);
#pragma unroll
                for (int bj = 0; bj < 2; ++bj)
#pragma unroll
                    for (int n = 0; n < 2; ++n) { const u32x2 bb = b[bj][n]; const f32x4 a = acc[ai][bj][m][n];
                        const f32x4 o = (f32x4){__uint_as_float(bb.x << 16) + a[0], __uint_as_float(bb.x & 0xffff0000u) + a[1], __uint_as_float(bb.y << 16) + a[2], __uint_as_float(bb.y & 0xffff0000u) + a[3]};
                        u32x2 w; w.x = cvt_pk_bf16(o[0], o[1]); w.y = cvt_pk_bf16(o[2], o[3]);
                        *(u32x2*)(hb + off + bj * HALF + n * 16) = w; s += (o[0] * o[0] + o[1] * o[1]) + (o[2] * o[2] + o[3] * o[3]); }
                s += __shfl_xor(s, 16); s += __shfl_xor(s, 32);
                if (fq == 0) P[rl * 4 + wc] = s;
                if (m & 1) asm volatile("" ::: "memory"); }
        asm volatile("s_waitcnt lgkmcnt(0)" ::: "memory"); __builtin_amdgcn_s_barrier(); asm volatile("" ::: "memory");
        const int tid = wid * 64 + lane;
        if (tid < 256) { const float t = (P[tid * 4 + 0] + P[tid * 4 + 1]) + (P[tid * 4 + 2] + P[tid * 4 + 3]); ssq[(size_t)(u.pm * BM + tid) * 4 + u.pn] = t; }
        asm volatile("s_waitcnt lgkmcnt(0)" ::: "memory"); __builtin_amdgcn_s_barrier(); asm volatile("" ::: "memory");
    }
};

template <class Epi, class Sched, bool ALIGN_EPI = false, bool SP2 = false>
__device__ __forceinline__ void gemm_phase(PG8_LAS unsigned char* lds, const Gemm g, const Sched& S, const Epi& E, const int wave_id  ) {
    int tid_ = wave_id * 64 + (int)__builtin_amdgcn_mbcnt_hi(~0u, __builtin_amdgcn_mbcnt_lo(~0u, 0u)); asm volatile("" : "+v"(tid_));
    const int tid = tid_, wid = __builtin_amdgcn_readfirstlane(tid >> 6), lane = tid & 63, wr = wid >> 2, wc = wid & 3, fr = lane & 15, fq = lane >> 4;
    const int K = g.K, nt = K / BK;
    unsigned voffA[2], voffB[2];
#pragma unroll
    for (int i = 0; i < 2; ++i) { int R, C; stage_rc(tid * 16 + i * 8192, R, C); const int Rb = Epi::PERM ? ((R & ~31) + perm32(R & 31)) : R;
        voffA[i] = (unsigned)(R * K + C) * 2u; voffB[i] = (unsigned)(Rb * K + C) * 2u; }
    const size_t kstep = (size_t)(BK * 2);
    const size_t hstep = (size_t)HALF * K * 2;
    const size_t tstep = 2 * hstep;
    const unsigned ldsw = (unsigned)wid * 1024u;
    const int aoff = lds_byte(wr * 64 + fr, fq * 8), boff = lds_byte(wc * 32 + fr, fq * 8);
#define PG8_SA(b, h) (((b) * 2 + (h)) * HTB)
#define PG8_SB(b, h) ((4 + (b) * 2 + (h)) * HTB)
#define PG8_STAGE(bufoff, gbase, voff) do { _Pragma("unroll") for (int _i = 0; _i < 2; ++_i) \
        __builtin_amdgcn_global_load_lds((const unsigned*)((const char*)(gbase) + (voff)[_i]), (PG8_LAS unsigned*)(lds + (bufoff) + ldsw + _i * 8192), 16, 0, 0); } while (0)
#define PG8_LDA(dst, b, h) do { _Pragma("unroll") for (int m = 0; m < 4; ++m) _Pragma("unroll") for (int k = 0; k < 2; ++k) dst[m][k] = *(const PG8_LAS bf16x8*)(lds + PG8_SA(b, h) + aoff + m * 2048 + k * 1024); } while (0)
#define PG8_LDB(dst, b, h) do { _Pragma("unroll") for (int n = 0; n < 2; ++n) _Pragma("unroll") for (int k = 0; k < 2; ++k) dst[n][k] = *(const PG8_LAS bf16x8*)(lds + PG8_SB(b, h) + boff + n * 2048 + k * 1024); } while (0)
#define PG8_MMA(ai, bj, At, Bt) do { __builtin_amdgcn_s_setprio(1); _Pragma("unroll") for (int m = 0; m < 4; ++m) _Pragma("unroll") for (int n = 0; n < 2; ++n) _Pragma("unroll") for (int k = 0; k < 2; ++k) \
        acc[ai][bj][m][n] = __builtin_amdgcn_mfma_f32_16x16x32_bf16(Bt[n][k], At[m][k], acc[ai][bj][m][n], 0, 0, 0); __builtin_amdgcn_s_setprio(0); } while (0)
#define PG8_WAIT_V(n) asm volatile("s_waitcnt vmcnt(" #n ")" ::: "memory")
#define PG8_WAIT_L(n) asm volatile("s_waitcnt lgkmcnt(" #n ")" ::: "memory")
#define PG8_BAR __builtin_amdgcn_s_barrier()
#define PG8_SCHED __builtin_amdgcn_sched_barrier(0)
    Unit cur, nxt; int ui = 0;
    if (!S.next(0, cur)) return;
    f32x4 acc[2][2][4][2];
#pragma unroll
    for (int a = 0; a < 2; ++a)
#pragma unroll
        for (int b = 0; b < 2; ++b)
#pragma unroll
            for (int m = 0; m < 4; ++m)
#pragma unroll
                for (int n = 0; n < 2; ++n) acc[a][b][m][n] = (f32x4){0.f, 0.f, 0.f, 0.f};
    bf16x8 At[4][2], B0[2][2], B1[2][2];
    const char* cA = (const char*)g.A + (size_t)cur.pm * tstep; const char* cB = (const char*)g.Bt + (size_t)cur.pn * tstep;
    S.a_ready(cur);
    if constexpr (SP2) {
        PG8_STAGE(PG8_SB(0, 0), cB, voffB); PG8_STAGE(PG8_SB(0, 1), cB + hstep, voffB); PG8_STAGE(PG8_SA(0, 0), cA, voffA); PG8_STAGE(PG8_SA(0, 1), cA + hstep, voffA);
        if (wr == 1) PG8_BAR;
        PG8_WAIT_V(2); PG8_BAR;
        PG8_STAGE(PG8_SB(1, 0), cB + kstep, voffB); PG8_STAGE(PG8_SA(1, 0), cA + kstep, voffA); PG8_STAGE(PG8_SB(1, 1), cB + hstep + kstep, voffB);
        PG8_WAIT_V(6); PG8_BAR;
    } else {
        PG8_STAGE(PG8_SB(0, 0), cB, voffB); PG8_STAGE(PG8_SA(0, 0), cA, voffA); PG8_STAGE(PG8_SB(0, 1), cB + hstep, voffB); PG8_STAGE(PG8_SA(0, 1), cA + hstep, voffA);
        if (wr == 1) PG8_BAR;
        PG8_WAIT_V(4); PG8_BAR;
        PG8_STAGE(PG8_SB(1, 0), cB + kstep, voffB); PG8_STAGE(PG8_SA(1, 0), cA + kstep, voffA); PG8_STAGE(PG8_SB(1, 1), cB + hstep + kstep, voffB);
        PG8_WAIT_V(6); PG8_BAR;
    }
    for (;;) {
        const bool has_next = S.next(ui + 1, nxt);
        const char* nA = has_next ? (const char*)g.A + (size_t)nxt.pm * tstep : cA; const char* nB = has_next ? (const char*)g.Bt + (size_t)nxt.pn * tstep : cB;
        for (int t = 0; t < nt; t += 2) {
            const bool last = (t == nt - 2);
            const char* a1 = cA + (size_t)(t + 1) * kstep;
            const char* a2 = last ? nA : cA + (size_t)(t + 2) * kstep; const char* b2 = last ? nB : cB + (size_t)(t + 2) * kstep;
            const char* a3 = a2 + kstep; const char* b3 = b2 + kstep;
            if (last && has_next) S.a_ready(nxt);
            if constexpr (SP2) {
            PG8_LDB(B0, 0, 0); PG8_LDB(B1, 0, 1); PG8_SCHED; PG8_LDA(At, 0, 0); PG8_STAGE(PG8_SA(1, 1), a1 + hstep, voffA);
            PG8_WAIT_V(8); PG8_WAIT_L(0); PG8_BAR; PG8_MMA(0, 0, At, B0); PG8_MMA(0, 1, At, B1); PG8_BAR; PG8_SCHED;
            PG8_LDA(At, 0, 1); PG8_STAGE(PG8_SB(0, 0), b2, voffB); PG8_STAGE(PG8_SB(0, 1), b2 + hstep, voffB); PG8_STAGE(PG8_SA(0, 0), a2, voffA);
            PG8_WAIT_V(8); PG8_WAIT_L(0); PG8_BAR; PG8_MMA(1, 0, At, B0); PG8_MMA(1, 1, At, B1); PG8_BAR; PG8_SCHED;
            PG8_LDB(B0, 1, 0); PG8_LDB(B1, 1, 1); PG8_SCHED; PG8_LDA(At, 1, 0); PG8_STAGE(PG8_SA(0, 1), a2 + hstep, voffA);
            PG8_WAIT_V(8); PG8_WAIT_L(0); PG8_BAR; PG8_MMA(0, 0, At, B0); PG8_MMA(0, 1, At, B1); PG8_BAR; PG8_SCHED;
            PG8_LDA(At, 1, 1); PG8_STAGE(PG8_SB(1, 0), b3, voffB); PG8_STAGE(PG8_SB(1, 1), b3 + hstep, voffB); PG8_STAGE(PG8_SA(1, 0), a3, voffA);
            PG8_WAIT_V(8); PG8_WAIT_L(0); PG8_BAR; PG8_MMA(1, 0, At, B0); PG8_MMA(1, 1, At, B1); PG8_BAR; PG8_SCHED;
            } else {
            PG8_LDB(B0, 0, 0); PG8_SCHED; PG8_LDA(At, 0, 0); PG8_STAGE(PG8_SA(1, 1), a1 + hstep, voffA);
            PG8_WAIT_L(8); PG8_BAR; PG8_WAIT_L(0); PG8_MMA(0, 0, At, B0); PG8_BAR; PG8_SCHED;
            PG8_LDB(B1, 0, 1); PG8_STAGE(PG8_SB(0, 0), b2, voffB);
            PG8_BAR; PG8_WAIT_L(0); PG8_MMA(0, 1, At, B1); PG8_BAR;
            PG8_LDA(At, 0, 1); PG8_STAGE(PG8_SA(0, 0), a2, voffA);
            PG8_BAR; PG8_WAIT_L(0); PG8_MMA(1, 0, At, B0); PG8_BAR; PG8_SCHED;
            PG8_STAGE(PG8_SB(0, 1), b2 + hstep, voffB);
            PG8_WAIT_V(6); PG8_BAR; PG8_MMA(1, 1, At, B1); PG8_BAR;
            PG8_LDB(B0, 1, 0); PG8_SCHED; PG8_LDA(At, 1, 0); PG8_STAGE(PG8_SA(0, 1), a2 + hstep, voffA);
            PG8_WAIT_L(8); PG8_BAR; PG8_WAIT_L(0); PG8_MMA(0, 0, At, B0); PG8_BAR; PG8_SCHED;
            PG8_LDB(B1, 1, 1); PG8_STAGE(PG8_SB(1, 0), b3, voffB);
            PG8_BAR; PG8_WAIT_L(0); PG8_MMA(0, 1, At, B1); PG8_BAR;
            PG8_LDA(At, 1, 1); PG8_STAGE(PG8_SA(1, 0), a3, voffA);
            PG8_BAR; PG8_WAIT_L(0); PG8_MMA(1, 0, At, B0); PG8_BAR; PG8_SCHED;
            PG8_STAGE(PG8_SB(1, 1), b3 + hstep, voffB);
            PG8_WAIT_V(6); PG8_BAR; PG8_MMA(1, 1, At, B1); PG8_BAR;
            }
        }
        if constexpr (ALIGN_EPI) { if (wr == 0) PG8_BAR; }
        if constexpr (!Epi::AFTER_DRAIN) { E(acc, cur, wr, wc, fr, fq); S.done(cur); }
        if (!has_next) break;
#pragma unroll
        for (int a = 0; a < 2; ++a)
#pragma unroll
            for (int b = 0; b < 2; ++b)
#pragma unroll
                for (int m = 0; m < 4; ++m)
#pragma unroll
                    for (int n = 0; n < 2; ++n) acc[a][b][m][n] = (f32x4){0.f, 0.f, 0.f, 0.f};
        cur = nxt; cA = nA; cB = nB; ++ui;
        if constexpr (ALIGN_EPI) { if (wr == 1) PG8_BAR; }
    }
    PG8_WAIT_V(0);
    if constexpr (!ALIGN_EPI) { if (wr == 0) PG8_BAR; }
    PG8_BAR;
    if constexpr (Epi::AFTER_DRAIN) { E.fused(acc, cur, wr, wc, fr, fq, lds, wid, lane); S.done(cur); }
#undef PG8_SA
#undef PG8_SB
#undef PG8_STAGE
#undef PG8_LDA
#undef PG8_LDB
#undef PG8_MMA
#undef PG8_WAIT_V
#undef PG8_WAIT_L
#undef PG8_BAR
#undef PG8_SCHED
}
}

constexpr int NWAVES = 8;
#ifndef MK_N_LAUNCHES
#define MK_N_LAUNCHES 1
#endif
constexpr int N_PHASES = 12;
constexpr int BATCH = 8, T = 2048, D = 1024, M = BATCH * T, DEPTH = 2;
constexpr int NPROJ = 3072, IN_DIM = 3080, QKV = 1536, DFF = 2816, NGU = 2 * DFF;
constexpr int NH = 4, DK = 128, CH = 64, NCH = T / CH;
constexpr int GMC = 128;
constexpr size_t WS_CTL = 0, CTL_BYTES = 1u << 20;
constexpr size_t SZ_WIN = (size_t)NPROJ * D * 2, SZ_WBA = 16 * D * 2, SZ_WOUT = (size_t)D * D * 2, SZ_WGU = (size_t)NGU * D * 2, SZ_WDN = (size_t)D * DFF * 2, SZ_WSB = 4 * 128 * 128 * 2;
constexpr size_t SZ_WL = SZ_WIN + SZ_WBA + SZ_WOUT + SZ_WGU + SZ_WDN + SZ_WSB;
constexpr size_t WS_W = WS_CTL + CTL_BYTES;
constexpr size_t OFF_WIN = 0, OFF_WBA = OFF_WIN + SZ_WIN, OFF_WOUT = OFF_WBA + SZ_WBA, OFF_WGU = OFF_WOUT + SZ_WOUT, OFF_WDN = OFF_WGU + SZ_WGU, OFF_WSB = OFF_WDN + SZ_WDN;
constexpr size_t WS_BG = WS_W + DEPTH * SZ_WL;
constexpr size_t WS_SSQ = WS_BG + (size_t)M * 8 * 4;
constexpr size_t WS_HB = WS_SSQ + (size_t)M * 4 * 4;
constexpr size_t WS_R = WS_HB + (size_t)M * D * 2;
constexpr size_t WS_QKV = WS_R;
constexpr size_t WS_OCAT = WS_QKV + (size_t)M * QKV * 2;
constexpr size_t WS_VG = WS_OCAT + (size_t)M * D * 2;
constexpr size_t WS_RING = WS_VG + (size_t)M * 512 * 2;
constexpr size_t WS_HID = WS_R;
constexpr int SL_WN = 0, SL_QG = 16384, SL_KGT = 32768, SL_QK = 49152, SL_UT = 57344, SL_MISC = 73728, SLOT_BYTES = 73984;
constexpr size_t WS_SSAVE = WS_RING + (size_t)32 * NCH * SLOT_BYTES;
constexpr size_t WS_END = WS_SSAVE + (size_t)32 * 512 * 128;
static_assert((size_t)M * DFF * 2 <= WS_RING - WS_R, "hidden overlay fits");
static_assert(WS_END <= 268435456ull, "d_ws map fits 256 MiB");
constexpr int CW_BAR = 4096;
constexpr int CW_FLAG = 16384;
static_assert((CW_FLAG + 2 * 32 * 32 * 16) * 4 <= (int)CTL_BYTES, "ctl words");
constexpr int RING_BYTES = 131072, LDS_BYTES = 147456, CTL_OFF = LDS_BYTES - 1024, MISC_OFF = CTL_OFF + 320;

#define GAS __attribute__((address_space(1)))
#define LAS __attribute__((address_space(3)))
typedef unsigned short bf16;
typedef unsigned v4u __attribute__((ext_vector_type(4)));
typedef unsigned v2u __attribute__((ext_vector_type(2)));
typedef float f32x4 __attribute__((ext_vector_type(4)));
typedef float f32x2 __attribute__((ext_vector_type(2)));
typedef short bf16x8 __attribute__((ext_vector_type(8)));
typedef short bf16x4 __attribute__((ext_vector_type(4)));
typedef GAS unsigned gu32;
#define RLX_AGENT __ATOMIC_RELAXED, __HIP_MEMORY_SCOPE_AGENT
#define LDS_WAIT() asm volatile("s_waitcnt lgkmcnt(0)" ::: "memory")
#define VM_WAIT() asm volatile("s_waitcnt vmcnt(0)" ::: "memory")
__device__ __forceinline__ unsigned pk2(float lo, float hi) { return pg8::cvt_pk_bf16(lo, hi); }
__device__ __forceinline__ float bf_lo(unsigned u) { return __uint_as_float(u << 16); }
__device__ __forceinline__ float bf_hi(unsigned u) { return __uint_as_float(u & 0xffff0000u); }
__device__ __forceinline__ float bf2f(unsigned short s) { return __uint_as_float((unsigned)s << 16); }
__device__ __forceinline__ float wave_sum(float v) {
#pragma unroll
    for (int o = 1; o < 64; o <<= 1) v += __shfl_xor(v, o);
    return v;
}
__device__ __forceinline__ bf16x8 mk8(v2u a, v2u b) { v4u t; t.x = a.x; t.y = a.y; t.z = b.x; t.w = b.y; return __builtin_bit_cast(bf16x8, t); }
__device__ __forceinline__ v2u pk4(f32x4 v) { v2u r; r.x = pk2(v[0], v[1]); r.y = pk2(v[2], v[3]); return r; }
__device__ __forceinline__ v2u pk4n(f32x4 v) { v2u r; r.x = pk2(-v[0], -v[1]); r.y = pk2(-v[2], -v[3]); return r; }
#define MFMA16(a, b, c) __builtin_amdgcn_mfma_f32_16x16x32_bf16((a), (b), (c), 0, 0, 0)
__device__ __forceinline__ int kperm(int c) { const int cc = c & 31; return (c & ~31) + 8 * ((cc & 15) >> 2) + 4 * (cc >> 4) + (cc & 3); }
__device__ __forceinline__ void st8_wt(__amdgpu_buffer_rsrc_t r, unsigned off, v2u v) { __builtin_amdgcn_raw_buffer_store_b64(v, r, (int)off, 0, 16); }
__device__ __forceinline__ void st16_wt(__amdgpu_buffer_rsrc_t r, unsigned off, v4u v) { __builtin_amdgcn_raw_buffer_store_b128(v, r, (int)off, 0, 16); }

#define XB_TMO      128
#define XB_XCNT(j)  (256  + 64 * (j))
#define XB_XSUB(j)  (1280 + 64 * (j))
#define XB_XGEN(j)  (2304 + 64 * (j))
#define XB_TOP      3328
#define XB_TOPGEN   3392
#define XCD_BAR_WORDS 3456
#define XB_SPIN_CAP (1u << 18)
__device__ __forceinline__ unsigned xb_ld(unsigned* p)              { return __hip_atomic_load(p, __ATOMIC_RELAXED, __HIP_MEMORY_SCOPE_AGENT); }
__device__ __forceinline__ unsigned xb_add(unsigned* p, unsigned v) { return __hip_atomic_fetch_add(p, v, __ATOMIC_RELAXED, __HIP_MEMORY_SCOPE_AGENT); }
__device__ __forceinline__ unsigned xb_xcc_id() { return (unsigned)__builtin_amdgcn_s_getreg((3 << 11) | 20) & 0xFu; }
#define XB_SPIN(cond, bar) do { unsigned _sp = 0; while (cond) { __builtin_amdgcn_s_sleep(1); \
    if ((++_sp & 255u) == 0u) { if (xb_ld(&(bar)[XB_TMO])) break; if (_sp > XB_SPIN_CAP) { atomicAdd(&(bar)[XB_TMO], 1u); break; } } } } while (0)
struct XcdBarrier { unsigned* bar; unsigned x; volatile LAS unsigned* st; };
__device__ __forceinline__ XcdBarrier xcd_barrier_post(unsigned* bar, volatile LAS unsigned* st) {
    XcdBarrier b; b.bar = bar; b.x = xb_xcc_id(); b.st = st;
    if (threadIdx.x == 0) (void)xb_add(&bar[XB_XCNT(b.x)], 1u);
    return b;
}
__device__ __forceinline__ void xcd_barrier_complete(unsigned* bar, unsigned x, unsigned& nloc, unsigned& nx) {
    const unsigned G = gridDim.x * gridDim.y * gridDim.z;
    unsigned sum, cnt, mine, sp = 0u;
    for (;;) {
        sum = 0u; cnt = 0u; mine = 0u;
#pragma unroll
        for (unsigned j = 0; j < 16; ++j) { const unsigned c = xb_ld(&bar[XB_XCNT(j)]); sum += c; cnt += (c > 0u) ? 1u : 0u; mine = (j == x) ? c : mine; }
        if (sum == G) break;
        __builtin_amdgcn_s_sleep(1);
        if ((++sp & 255u) == 0u) { if (xb_ld(&bar[XB_TMO])) break; if (sp > XB_SPIN_CAP) { atomicAdd(&bar[XB_TMO], 1u); break; } }
    }
    nloc = mine > 0u ? mine : 1u; nx = cnt > 0u ? cnt : 1u;
}
__device__ __forceinline__ void xcd_barrier(const XcdBarrier& b, const int wave_id) {
    asm volatile("s_waitcnt vmcnt(0)" ::: "memory");
    __syncthreads();
    if (wave_id == 0 && __builtin_amdgcn_mbcnt_hi(~0u, __builtin_amdgcn_mbcnt_lo(~0u, 0u)) == 0u) {
        unsigned* bar = b.bar;
        __builtin_amdgcn_s_waitcnt(0);
        unsigned nloc = b.st[0], nx = b.st[1];
        if (nloc == 0u) { xcd_barrier_complete(bar, b.x, nloc, nx); b.st[0] = nloc; b.st[1] = nx; }
        const unsigned old = xb_add(&bar[XB_XSUB(b.x)], 1u);
        const unsigned gen = old / nloc;
        if (old + 1u == (gen + 1u) * nloc) {
            __builtin_amdgcn_fence(__ATOMIC_RELEASE, "agent");
            asm volatile("s_waitcnt vmcnt(0)" ::: "memory");
            const unsigned og = xb_add(&bar[XB_TOP], 1u);
            const unsigned tg = og / nx;
            if (og + 1u == (tg + 1u) * nx) xb_add(&bar[XB_TOPGEN], 1u);
            else XB_SPIN(xb_ld(&bar[XB_TOPGEN]) == tg, bar);
            __builtin_amdgcn_fence(__ATOMIC_ACQUIRE, "agent");
            xb_add(&bar[XB_XGEN(b.x)], 1u);
            asm volatile("s_waitcnt vmcnt(0)" ::: "memory");
        } else {
            XB_SPIN(xb_ld(&bar[XB_XGEN(b.x)]) == gen, bar);
            __builtin_amdgcn_fence(__ATOMIC_ACQUIRE, "agent");
            asm volatile("s_waitcnt vmcnt(0)" ::: "memory");
        }
    }
    __syncthreads();
}

struct Args { const float* in[17]; float* out; unsigned char* ws; int ph_lo, ph_hi; };
#define CAS __attribute__((address_space(4)))
struct Frame {
    LAS unsigned char* lds;
    int tid, lane, wave, G, vcu;
    const CAS Args* A;
};
struct LayerW { bf16 *win, *wba, *wout, *wgu, *wdn, *wsb; };
__device__ __forceinline__ LayerW layer_w(unsigned char* ws, int l) {
    unsigned char* b = ws + WS_W + (size_t)l * SZ_WL; LayerW w;
    w.win = (bf16*)(b + OFF_WIN); w.wba = (bf16*)(b + OFF_WBA); w.wout = (bf16*)(b + OFF_WOUT); w.wgu = (bf16*)(b + OFF_WGU); w.wdn = (bf16*)(b + OFF_WDN); w.wsb = (bf16*)(b + OFF_WSB);
    return w;
}

__device__ __forceinline__ void p0_transpose_item(const float* W, int K, int N, int k0, int nsrc0, bf16* WT, int drow0, const float* scale, LAS float* scr, int lane) {
#pragma unroll 8
    for (int i = 0; i < 32; ++i) { const int kk = 2 * i + (lane >> 5); float v = W[(size_t)(k0 + kk) * N + nsrc0 + (lane & 31)]; if (scale) v *= scale[k0 + kk]; scr[kk * 33 + (lane & 31)] = v; }
    LDS_WAIT(); asm volatile("" ::: "memory");
    const int c = lane & 7;
#pragma unroll
    for (int j = 0; j < 4; ++j) { const int n = (lane >> 3) + 8 * j; const LAS float* s = scr + (8 * c) * 33 + n;
        v4u o; o.x = pk2(s[0 * 33], s[1 * 33]); o.y = pk2(s[2 * 33], s[3 * 33]); o.z = pk2(s[4 * 33], s[5 * 33]); o.w = pk2(s[6 * 33], s[7 * 33]);
        *(GAS v4u*)(WT + (size_t)(drow0 + n) * K + k0 + 8 * c) = o; }
    LDS_WAIT(); asm volatile("" ::: "memory");
}
__device__ __forceinline__ void p0_weights(Frame& F, const bool late, const int gw, const int NGW) {
    LAS float* scr = (LAS float*)(F.lds + F.wave * 16384);
    constexpr int I_IN = (D / 64) * (NPROJ / 32), I_OUT = (D / 64) * (D / 32), I_GU = (D / 64) * (NGU / 32), I_DN = (DFF / 64) * (D / 32), I_L = I_IN + I_OUT + I_GU + I_DN;
    const int lo = late ? I_IN : 0, hi = late ? DEPTH * I_L : I_IN;
    for (int it = lo + gw; it < hi; it += NGW) {
        const int l = it / I_L; int r = it % I_L; const LayerW w = layer_w(F.A->ws, l);
        if (r < I_IN) { const int nb = r % (NPROJ / 32), kb = r / (NPROJ / 32); const int nd = nb * 32, ns = nd + (nd >= 2048 ? 8 : 0);
            p0_transpose_item(F.A->in[2] + (size_t)l * D * IN_DIM, D, IN_DIM, kb * 64, ns, w.win, nd, F.A->in[1] + l * D, scr, F.lane); continue; } r -= I_IN;
        if (r < I_OUT) { const int nb = r % (D / 32), kb = r / (D / 32);
            p0_transpose_item(F.A->in[11] + (size_t)l * D * D, D, D, kb * 64, nb * 32, w.wout, nb * 32, nullptr, scr, F.lane); continue; } r -= I_OUT;
        if (r < I_GU) { const int nb = r % (NGU / 32), kb = r / (NGU / 32); const int tile = nb >> 3, j = nb & 7;
            const float* src = (j < 4 ? F.A->in[13] : F.A->in[14]) + (size_t)l * D * DFF;
            p0_transpose_item(src, D, DFF, kb * 64, tile * 128 + (j & 3) * 32, w.wgu, nb * 32, F.A->in[12] + l * D, scr, F.lane); continue; } r -= I_GU;
        { const int nb = r % (D / 32), kb = r / (D / 32);
            p0_transpose_item(F.A->in[15] + (size_t)l * DFF * D, DFF, D, kb * 64, nb * 32, w.wdn, nb * 32, nullptr, scr, F.lane); }
    }
}
__device__ __forceinline__ void p0_prologue(Frame& F) {
    const int gw = F.vcu * NWAVES + F.wave, NGW = F.G * NWAVES;
    p0_weights(F, false, gw, NGW);
    const int gt = F.vcu * (NWAVES * 64) + F.tid, NGT = F.G * NWAVES * 64;
    for (int i = gt; i < DEPTH * 16 * D; i += NGT) { const int l = i / (16 * D), j = (i / D) & 15, k = i % D;
        const float v = j < 8 ? F.A->in[2][(size_t)l * D * IN_DIM + (size_t)k * IN_DIM + 2048 + j] * F.A->in[1][l * D + k] : 0.f;
        layer_w(F.A->ws, l).wba[j * D + k] = (bf16)(pk2(v, 0.f) & 0xffffu); }
    for (int i = gt; i < DEPTH * 4 * 128 * 128; i += NGT) { const int l = i / (4 * 128 * 128), e = i % (4 * 128 * 128), t = (e >> 7) & 127, s = e & 127;
        const float v = (t >= s) ? F.A->in[9][i] : 0.f; layer_w(F.A->ws, l).wsb[e] = (bf16)(pk2(v, 0.f) & 0xffffu); }
    bf16* hb = (bf16*)(F.A->ws + WS_HB); float* ssq = (float*)(F.A->ws + WS_SSQ);
    for (int m = gw; m < M; m += NGW) {
        const GAS f32x4* xr = (const GAS f32x4*)(F.A->in[0] + (size_t)m * D) + F.lane; f32x4 v[4]; float s = 0.f;
#pragma unroll
        for (int j = 0; j < 4; ++j) { v[j] = xr[64 * j]; s += (v[j].x * v[j].x + v[j].y * v[j].y) + (v[j].z * v[j].z + v[j].w * v[j].w); }
        s = wave_sum(s);
        GAS v2u* o8 = (GAS v2u*)(hb + (size_t)m * D) + F.lane;
#pragma unroll
        for (int j = 0; j < 4; ++j) { v2u o; o.x = pk2(v[j].x, v[j].y); o.y = pk2(v[j].z, v[j].w); o8[64 * j] = o; }
        if (F.lane == 0) *(GAS f32x4*)(ssq + (size_t)m * 4) = (f32x4){s, 0.f, 0.f, 0.f};
    }
}

__device__ __forceinline__ void ba_rows(Frame& F, int l, int row0) {
    const bf16* hb = (const bf16*)(F.A->ws + WS_HB); const bf16* wba = layer_w(F.A->ws, l).wba; const float* ssq = (const float*)(F.A->ws + WS_SSQ); float* bg = (float*)(F.A->ws + WS_BG);
    const int fr = F.lane & 15, fq = F.lane >> 4, w = F.wave;
    f32x4 acc[4];
#pragma unroll
    for (int m = 0; m < 4; ++m) acc[m] = (f32x4){0.f, 0.f, 0.f, 0.f};
#pragma unroll
    for (int ks = 0; ks < 4; ++ks) { const int k0 = 128 * w + 32 * ks + 8 * fq;
        const bf16x8 b = *(const GAS bf16x8*)(wba + (size_t)fr * D + k0);
#pragma unroll
        for (int m = 0; m < 4; ++m) { const bf16x8 a = *(const GAS bf16x8*)(hb + (size_t)(row0 + 16 * m + fr) * D + k0); acc[m] = MFMA16(a, b, acc[m]); } }
    LAS float* part = (LAS float*)F.lds;
#pragma unroll
    for (int m = 0; m < 4; ++m)
#pragma unroll
        for (int r = 0; r < 4; ++r) part[(w * 64 + 16 * m + 4 * fq + r) * 16 + fr] = acc[m][r];
    LDS_WAIT(); __syncthreads();
    { const int row = F.tid >> 3, j = F.tid & 7; float s = 0.f;
#pragma unroll
      for (int ww = 0; ww < 8; ++ww) s += part[(ww * 64 + row) * 16 + j];
      s *= pg8::row_rs(ssq, row0 + row);
      float o;
      if (j < 4) o = 1.0f / (1.0f + __expf(-s));
      else { const float z = s + F.A->in[5][l * 4 + (j - 4)]; const float sp = z > 20.f ? z : log1pf(__expf(z)); o = -__expf(F.A->in[4][l * 4 + (j - 4)]) * sp; }
      bg[(size_t)(row0 + row) * 8 + j] = o; }
    __syncthreads();
}

constexpr int PK_KB = 0, PK_QB = 17408, PK_VT = 34816, PK_KT = 69632, PK_AF = 104448, PK_TD = 121856, PK_GC = 124928, PK_QKT = 132096;
constexpr int SC_W = 0, SC_Q = 18432, SC_K = 36864, SC_QK = 57344, SC_O = 67584, SC_OSZ = 33792, SC_OG = SC_O + 2 * SC_OSZ;

__device__ __forceinline__ void delta_prep_item(Frame& F, int l, int b, int h, int n, unsigned char* slot, gu32* flag) {
    const __amdgpu_buffer_rsrc_t srs = __builtin_amdgcn_make_buffer_rsrc(slot, 0, SLOT_BYTES, 0x00020000);
    const bf16* qkv = (const bf16*)(F.A->ws + WS_QKV); const float* bg = (const float*)(F.A->ws + WS_BG); const float* convw = F.A->in[3] + (size_t)l * 4 * QKV;
    LAS unsigned char* L = F.lds; int lane_ = F.lane; asm volatile("" : "+v"(lane_));
    const int lane = lane_, w = F.wave, tid = w * 64 + lane, fr = lane & 15, fq = lane >> 4;
    const int t0 = n * CH, R0 = b * T + t0;
    float gc, bval;
    { const float gv = bg[(size_t)(R0 + lane) * 8 + 4 + h]; bval = bg[(size_t)(R0 + lane) * 8 + h]; gc = gv;
#pragma unroll
      for (int o = 1; o < 64; o <<= 1) { const float t = __shfl_up(gc, o); if (lane >= o) gc += t; } }
    const float glast = __shfl(gc, 63);
    if (w == 0) { ((LAS float*)(L + PK_GC))[lane] = gc; ((LAS float*)(L + PK_GC))[64 + lane] = bval; }
    float eg[8], ek[8], be[8];
#pragma unroll
    for (int i = 0; i < 8; ++i) { const float g_i = __shfl(gc, 8 * w + i); eg[i] = __expf(g_i); ek[i] = __expf(glast - g_i); be[i] = __shfl(bval, 8 * w + i); }
#ifndef SK_A
    const int ch = 2 * lane;
#pragma unroll 1
    for (int X = 0; X < 3; ++X) { const int XX = (X == 0) ? 1 : (X == 1 ? 0 : 2);
        const int colx = XX * 512 + h * 128 + ch;
        float cw0[4], cw1[4];
#pragma unroll
        for (int j = 0; j < 4; ++j) { const f32x2 c2 = *(const GAS f32x2*)(convw + (size_t)j * QKV + colx); cw0[j] = c2.x; cw1[j] = c2.y; }
        float x0[11], x1[11];
#pragma unroll
        for (int rr = 0; rr < 11; ++rr) { const int tt = t0 + 8 * w + rr - 3; unsigned u = 0u; if (tt >= 0) u = *(const GAS unsigned*)(qkv + (size_t)(R0 + 8 * w + rr - 3) * QKV + colx); x0[rr] = bf_lo(u); x1[rr] = bf_hi(u); }
        float y0[8], y1[8];
#pragma unroll
        for (int i = 0; i < 8; ++i) { float a0 = 0.f, a1 = 0.f;
#pragma unroll
            for (int j = 0; j < 4; ++j) { a0 += cw0[j] * x0[i + j]; a1 += cw1[j] * x1[i + j]; }
            y0[i] = pg8::silu_f(a0); y1[i] = pg8::silu_f(a1); }
        if (XX < 2) {
#pragma unroll
            for (int i = 0; i < 8; ++i) { const float sq = wave_sum(y0[i] * y0[i] + y1[i] * y1[i]); const float rn = (XX == 0 ? 0.08838834764831845f : 1.0f) / sqrtf(sq + 1e-6f); y0[i] *= rn; y1[i] *= rn; } }
        if (XX == 0) {
#pragma unroll
            for (int i = 0; i < 8; ++i) { const int c = 8 * w + i;
                *(LAS unsigned*)(L + PK_QB + c * 272 + ch * 2) = pk2(y0[i], y1[i]); }
        } else if (XX == 1) {
#pragma unroll
            for (int i = 0; i < 8; ++i) { const int c = 8 * w + i; *(LAS unsigned*)(L + PK_KB + c * 272 + ch * 2) = pk2(y0[i], y1[i]); }
            { const int pa = kperm(8 * w), pb = kperm(8 * w + 4);
              st8_wt(srs, SL_KGT + ((ch) * 64 + pa) * 2, (v2u){pk2(y0[0] * ek[0], y0[1] * ek[1]), pk2(y0[2] * ek[2], y0[3] * ek[3])});
              st8_wt(srs, SL_KGT + ((ch) * 64 + pb) * 2, (v2u){pk2(y0[4] * ek[4], y0[5] * ek[5]), pk2(y0[6] * ek[6], y0[7] * ek[7])});
              st8_wt(srs, SL_KGT + ((ch + 1) * 64 + pa) * 2, (v2u){pk2(y1[0] * ek[0], y1[1] * ek[1]), pk2(y1[2] * ek[2], y1[3] * ek[3])});
              st8_wt(srs, SL_KGT + ((ch + 1) * 64 + pb) * 2, (v2u){pk2(y1[4] * ek[4], y1[5] * ek[5]), pk2(y1[6] * ek[6], y1[7] * ek[7])}); }
            LAS float* kt = (LAS float*)(L + PK_KT + ch * 272 + 8 * w * 4);
            *(LAS f32x4*)kt = (f32x4){y0[0] * be[0] * eg[0], y0[1] * be[1] * eg[1], y0[2] * be[2] * eg[2], y0[3] * be[3] * eg[3]};
            *(LAS f32x4*)(kt + 4) = (f32x4){y0[4] * be[4] * eg[4], y0[5] * be[5] * eg[5], y0[6] * be[6] * eg[6], y0[7] * be[7] * eg[7]};
            *(LAS f32x4*)(kt + 68) = (f32x4){y1[0] * be[0] * eg[0], y1[1] * be[1] * eg[1], y1[2] * be[2] * eg[2], y1[3] * be[3] * eg[3]};
            *(LAS f32x4*)(kt + 72) = (f32x4){y1[4] * be[4] * eg[4], y1[5] * be[5] * eg[5], y1[6] * be[6] * eg[6], y1[7] * be[7] * eg[7]};
        } else {
            LAS float* vt = (LAS float*)(L + PK_VT + ch * 272 + 8 * w * 4);
            *(LAS f32x4*)vt = (f32x4){y0[0] * be[0], y0[1] * be[1], y0[2] * be[2], y0[3] * be[3]};
            *(LAS f32x4*)(vt + 4) = (f32x4){y0[4] * be[4], y0[5] * be[5], y0[6] * be[6], y0[7] * be[7]};
            *(LAS f32x4*)(vt + 68) = (f32x4){y1[0] * be[0], y1[1] * be[1], y1[2] * be[2], y1[3] * be[3]};
            *(LAS f32x4*)(vt + 72) = (f32x4){y1[4] * be[4], y1[5] * be[5], y1[6] * be[6], y1[7] * be[7]};
        }
        asm volatile("" ::: "memory");
    }
#endif
    if (tid == 0) st16_wt(srs, SL_MISC, (v4u){__float_as_uint(__expf(glast)), 0u, 0u, 0u});
    LDS_WAIT(); __syncthreads();
    const LAS float* GC = (const LAS float*)(L + PK_GC); const LAS float* BE = GC + 64;
#ifndef SK_B1
    for (int fi = w; fi < 10; fi += 8) { const int mb = fi >= 6 ? 3 : (fi >= 3 ? 2 : (fi >= 1 ? 1 : 0)), sb = fi - (mb * (mb + 1)) / 2;
        f32x4 acc = (f32x4){0.f, 0.f, 0.f, 0.f};
#pragma unroll
        for (int ks = 0; ks < 4; ++ks) { const bf16x8 a = *(const LAS bf16x8*)(L + PK_KB + (16 * mb + fr) * 272 + (32 * ks + 8 * fq) * 2); const bf16x8 bb = *(const LAS bf16x8*)(L + PK_KB + (16 * sb + fr) * 272 + (32 * ks + 8 * fq) * 2); acc = MFMA16(a, bb, acc); }
        const int s = 16 * sb + fr; const float gs = GC[s];
#pragma unroll
        for (int r = 0; r < 4; ++r) { const int c = 16 * mb + 4 * fq + r; const float v = (c > s) ? acc[r] * BE[c] * __expf(fminf(GC[c] - gs, 0.f)) : 0.f; ((LAS float*)(L + PK_AF))[c * 68 + s] = v; } }
#endif
    LDS_WAIT(); __syncthreads();
#ifndef SK_C
    if (w < 4) { const int cc = fr; float t[16];
#pragma unroll
        for (int j = 0; j < 16; ++j) t[j] = (j == cc) ? 1.f : 0.f;
#pragma unroll
        for (int r = 1; r < 16; ++r) { const LAS f32x4* arow = (const LAS f32x4*)((const LAS float*)(L + PK_AF) + (16 * w + r) * 68 + 16 * w); float a = t[r];
            f32x4 av[4];
#pragma unroll
            for (int j4 = 0; j4 < 4; ++j4) if (4 * j4 < r) av[j4] = arow[j4];
#pragma unroll
            for (int j = 0; j < r; ++j) a -= av[j >> 2][j & 3] * t[j];
            t[r] = a; asm volatile("" ::: "memory"); }
        if (lane < 16) {
#pragma unroll
            for (int r = 0; r < 16; ++r) *(LAS unsigned short*)(L + PK_TD + (16 * w + r) * 48 + cc * 2) = (unsigned short)(pk2(r == cc ? 0.f : t[r], 0.f) & 0xffffu); }
    } else { const int mb = w - 4; const int c = 16 * mb + fr; const float gcc = GC[c];
#pragma unroll 1
        for (int sb = 0; sb < 4; ++sb) { v2u o; o.x = 0u; o.y = 0u;
            if (sb <= mb) { f32x4 acc = (f32x4){0.f, 0.f, 0.f, 0.f};
#pragma unroll
                for (int ks = 0; ks < 4; ++ks) { const bf16x8 kf = *(const LAS bf16x8*)(L + PK_KB + (16 * sb + fr) * 272 + (32 * ks + 8 * fq) * 2); const bf16x8 qf = *(const LAS bf16x8*)(L + PK_QB + (16 * mb + fr) * 272 + (32 * ks + 8 * fq) * 2); acc = MFMA16(kf, qf, acc); }
                f32x4 v;
#pragma unroll
                for (int r = 0; r < 4; ++r) { const int s = 16 * sb + 4 * fq + r; v[r] = (c >= s) ? acc[r] * __expf(fminf(gcc - GC[s], 0.f)) : 0.f; }
                o = pk4(v); }
            *(LAS v2u*)(L + PK_QKT + c * 144 + (32 * (sb >> 1) + 8 * fq + 4 * (sb & 1)) * 2) = o; } }
#endif
    LDS_WAIT(); __syncthreads();
#ifndef SK_D
    {
        const LAS float* AF = (const LAS float*)(L + PK_AF);
        const v2u z2 = (v2u){0u, 0u};
        bf16x8 td[4];
#pragma unroll
        for (int bb = 0; bb < 4; ++bb) td[bb] = mk8(*(const LAS v2u*)(L + PK_TD + (16 * bb + fr) * 48 + 4 * fq * 2), z2);
        const bf16x8 a10 = mk8(pk4n(*(const LAS f32x4*)(AF + (16 + fr) * 68 + 4 * fq)), z2);
        const bf16x8 a2x = mk8(pk4n(*(const LAS f32x4*)(AF + (32 + fr) * 68 + 4 * fq)), pk4n(*(const LAS f32x4*)(AF + (32 + fr) * 68 + 16 + 4 * fq)));
        const bf16x8 a3a = mk8(pk4n(*(const LAS f32x4*)(AF + (48 + fr) * 68 + 4 * fq)), pk4n(*(const LAS f32x4*)(AF + (48 + fr) * 68 + 16 + 4 * fq)));
        const bf16x8 a3b = mk8(pk4n(*(const LAS f32x4*)(AF + (48 + fr) * 68 + 32 + 4 * fq)), z2);
#pragma unroll
        for (int f = 0; f < 2; ++f) { const int n0 = 32 * w + 16 * f; const bool isU = n0 < 128; const int col = (n0 & 127) + fr;
            const LAS float* img = (const LAS float*)(L + (isU ? PK_VT : PK_KT) + col * 272);
            f32x4 X0 = *(const LAS f32x4*)(img + 4 * fq), X1 = *(const LAS f32x4*)(img + 16 + 4 * fq), X2 = *(const LAS f32x4*)(img + 32 + 4 * fq), X3 = *(const LAS f32x4*)(img + 48 + 4 * fq);
            X0 = MFMA16(td[0], mk8(pk4(X0), z2), X0);
            X1 = MFMA16(a10, mk8(pk4(X0), z2), X1); X1 = MFMA16(td[1], mk8(pk4(X1), z2), X1);
            const bf16x8 x01 = mk8(pk4(X0), pk4(X1));
            X2 = MFMA16(a2x, x01, X2); X2 = MFMA16(td[2], mk8(pk4(X2), z2), X2);
            X3 = MFMA16(a3a, x01, X3); X3 = MFMA16(a3b, mk8(pk4(X2), z2), X3); X3 = MFMA16(td[3], mk8(pk4(X3), z2), X3);
            if (isU) { LAS unsigned char* up = L + PK_VT + col * 272 + 4 * fq * 2;
                *(LAS v2u*)(up) = pk4(X0); *(LAS v2u*)(up + 32) = pk4(X1); *(LAS v2u*)(up + 64) = pk4(X2); *(LAS v2u*)(up + 96) = pk4(X3); }
            else { LAS unsigned char* wp = L + PK_KB + (4 * fq) * 272 + kperm(col) * 2;
#pragma unroll
                for (int r = 0; r < 4; ++r) { *(LAS unsigned short*)(wp + (r) * 272) = (unsigned short)(pk2(-X0[r], 0.f) & 0xffffu); *(LAS unsigned short*)(wp + (16 + r) * 272) = (unsigned short)(pk2(-X1[r], 0.f) & 0xffffu);
                    *(LAS unsigned short*)(wp + (32 + r) * 272) = (unsigned short)(pk2(-X2[r], 0.f) & 0xffffu); *(LAS unsigned short*)(wp + (48 + r) * 272) = (unsigned short)(pk2(-X3[r], 0.f) & 0xffffu); } }
        }
    }
#endif
    LDS_WAIT(); __syncthreads();
#pragma unroll
    for (int i = 0; i < 2; ++i) { const int idx = tid + 512 * i, row = idx >> 4, c16 = idx & 15;
        st16_wt(srs, SL_WN + row * 256 + c16 * 16, *(const LAS v4u*)(L + PK_KB + row * 272 + c16 * 16));
        const LAS unsigned char* qp = L + PK_QB + row * 272 + (32 * (c16 >> 2) + 4 * (c16 & 3)) * 2; const v2u qa = *(const LAS v2u*)qp, qb = *(const LAS v2u*)(qp + 32); const float e = __expf(GC[row]);
        st16_wt(srs, SL_QG + row * 256 + c16 * 16, (v4u){pk2(bf_lo(qa.x) * e, bf_hi(qa.x) * e), pk2(bf_lo(qa.y) * e, bf_hi(qa.y) * e), pk2(bf_lo(qb.x) * e, bf_hi(qb.x) * e), pk2(bf_lo(qb.y) * e, bf_hi(qb.y) * e)}); }
#pragma unroll
    for (int i = 0; i < 2; ++i) { const int idx = tid + 512 * i, row = idx >> 3, c16 = idx & 7; st16_wt(srs, SL_UT + row * 128 + c16 * 16, *(const LAS v4u*)(L + PK_VT + row * 272 + c16 * 16)); }
    { const int row = tid >> 3, c16 = tid & 7; st16_wt(srs, SL_QK + row * 128 + c16 * 16, *(const LAS v4u*)(L + PK_QKT + row * 144 + c16 * 16)); }
    asm volatile("s_waitcnt vmcnt(0)" ::: "memory");
    __syncthreads();
    if (tid == 0) __hip_atomic_store(flag, 1u, RLX_AGENT);
}

__device__ __forceinline__ void scan_spin(gu32* flag, gu32* tmo) {
    unsigned sp = 0;
    while ((unsigned)__builtin_amdgcn_readfirstlane(__hip_atomic_load(flag, RLX_AGENT)) == 0u) {
        __builtin_amdgcn_s_sleep(1);
        if ((++sp & 1023u) == 0u) { if (__hip_atomic_load(tmo, RLX_AGENT) != 0u) break; if (sp > (1u << 22)) { __hip_atomic_store(tmo, 1u, RLX_AGENT); break; } } }
}
#define AS_F4(x) __builtin_bit_cast(f32x4, (x))
#define AS_U4(x) __builtin_bit_cast(v4u, (x))
template <int BASE>
__device__ __forceinline__ void io_load(v4u (&R)[22], const unsigned char* slot, const bf16* zrow, int it) {
    const __amdgpu_buffer_rsrc_t r = __builtin_amdgcn_make_buffer_rsrc((void*)slot, 0, SLOT_BYTES, 0x00020000);
#pragma unroll
    for (int i = 0; i < 4; ++i) { const int idx = it + 256 * i;
        R[BASE + i] = __builtin_amdgcn_raw_buffer_load_b128(r, SL_WN + idx * 16, 0, 16); R[BASE + 4 + i] = __builtin_amdgcn_raw_buffer_load_b128(r, SL_QG + idx * 16, 0, 16); R[BASE + 8 + i] = __builtin_amdgcn_raw_buffer_load_b128(r, SL_KGT + idx * 16, 0, 16); }
#pragma unroll
    for (int i = 0; i < 2; ++i) R[BASE + 12 + i] = __builtin_amdgcn_raw_buffer_load_b128(r, SL_QK + (it + 256 * i) * 16, 0, 16);
#pragma unroll
    for (int i = 0; i < 4; ++i) R[BASE + 14 + i] = *(const GAS v4u*)(zrow + 8 * i);
}
template <int BASE>
__device__ __forceinline__ void io_stage(const v4u (&R)[22], LAS unsigned char* L, int it) {
#pragma unroll
    for (int i = 0; i < 4; ++i) { const int idx = it + 256 * i;
        *(LAS v4u*)(L + SC_W + (idx >> 4) * 288 + (idx & 15) * 16) = R[BASE + i]; *(LAS v4u*)(L + SC_Q + (idx >> 4) * 288 + (idx & 15) * 16) = R[BASE + 4 + i];
        *(LAS v4u*)(L + SC_K + (idx >> 3) * 160 + (idx & 7) * 16) = R[BASE + 8 + i]; }
#pragma unroll
    for (int i = 0; i < 2; ++i) { const int idx = it + 256 * i; *(LAS v4u*)(L + SC_QK + (idx >> 3) * 160 + (idx & 7) * 16) = R[BASE + 12 + i]; }
}
template <bool WRITE>
__device__ __forceinline__ void io_finalize(LAS unsigned char* L, int otile, const v4u (&R)[22], bf16* zp, int it) {
    const int seg = it & 3, row = it >> 2; const LAS float* orow = (const LAS float*)(L + SC_O + otile * SC_OSZ) + row * 132 + 32 * seg; const LAS f32x4* og = (const LAS f32x4*)(L + SC_OG) + 8 * seg;
    f32x4 v[8]; float s = 0.f;
#pragma unroll
    for (int j = 0; j < 8; ++j) { v[j] = *(const LAS f32x4*)(orow + 4 * j); s += (v[j].x * v[j].x + v[j].y * v[j].y) + (v[j].z * v[j].z + v[j].w * v[j].w); }
    s += __shfl_xor(s, 1); s += __shfl_xor(s, 2);
    const float rs = 1.0f / sqrtf(s * (1.0f / 128.0f) + 1e-6f);
#pragma unroll
    for (int i = 0; i < 4; ++i) { const v4u z = R[18 + i]; const unsigned zz[4] = {z.x, z.y, z.z, z.w}; unsigned oo[4];
#pragma unroll
        for (int j = 0; j < 4; ++j) { const f32x4 vv = v[2 * i + (j >> 1)], g4 = og[2 * i + (j >> 1)]; const int c0 = (2 * j) & 3; oo[j] = pk2(vv[c0] * rs * g4[c0] * bf_lo(zz[j]), vv[c0 + 1] * rs * g4[c0 + 1] * bf_hi(zz[j])); }
        if (WRITE) *(GAS v4u*)(zp + 8 * i) = (v4u){oo[0], oo[1], oo[2], oo[3]};
        else asm volatile("" :: "v"(oo[0]), "v"(oo[1]), "v"(oo[2]), "v"(oo[3])); }
}
template <bool WRITE, int BASE>
__device__ __forceinline__ void scan_step(Frame& F, int n, v4u (&R)[22], unsigned& fnext, gu32* flags, gu32* tmo, const unsigned char* slot0, bf16* ocat, int b, int h) {
    LAS unsigned char* L = F.lds; const int w = F.wave;
    int lane_ = F.lane; asm volatile("" : "+v"(lane_)); const int lane = lane_, fr = lane & 15, fq = lane >> 4, it = (w - 4) * 64 + lane;
    if (w >= 4) { io_stage<BASE>(R, L, it); if (n + 1 < NCH && w == 4 && fnext == 0u) scan_spin(flags + (n + 1) * 16, tmo); }
    LDS_WAIT(); __builtin_amdgcn_s_barrier(); asm volatile("" ::: "memory");
    if (w >= 4) {
        bf16* zrow = ocat + (size_t)(b * T + (it >> 2)) * D + h * 128 + 32 * (it & 3);
        v4u zc[4];
#pragma unroll
        for (int i = 0; i < 4; ++i) zc[i] = R[BASE + 14 + i];
        if (n + 1 < NCH) io_load<BASE>(R, slot0 + (size_t)(n + 1) * SLOT_BYTES, zrow + (size_t)(n + 1) * CH * D, it);
        if (w == 4 && n + 2 < NCH) fnext = __hip_atomic_load(flags + (n + 2) * 16, RLX_AGENT);
        if (n > 0) io_finalize<WRITE>(L, (n - 1) & 1, R, zrow + (size_t)(n - 1) * CH * D, it);
#pragma unroll
        for (int i = 0; i < 4; ++i) R[18 + i] = zc[i];
    } else {
        f32x4 vn[4][2], o[4][2];
#pragma unroll
        for (int m = 0; m < 4; ++m)
#pragma unroll
            for (int nf = 0; nf < 2; ++nf) { const v4u uu = R[16 + 2 * nf + (m >> 1)]; const unsigned ux = (m & 1) ? uu.z : uu.x, uy = (m & 1) ? uu.w : uu.y; vn[m][nf] = (f32x4){bf_lo(ux), bf_hi(ux), bf_lo(uy), bf_hi(uy)}; o[m][nf] = (f32x4){0.f, 0.f, 0.f, 0.f}; }
        const float dl = __uint_as_float(R[20].x);
        bf16x8 Sb[4][2];
#pragma unroll
        for (int ks = 0; ks < 4; ++ks)
#pragma unroll
            for (int nf = 0; nf < 2; ++nf) Sb[ks][nf] = mk8(pk4(AS_F4(R[2 * (2 * ks) + nf])), pk4(AS_F4(R[2 * (2 * ks + 1) + nf])));
        if (n + 1 < NCH) { const __amdgpu_buffer_rsrc_t r = __builtin_amdgcn_make_buffer_rsrc((void*)(slot0 + (size_t)(n + 1) * SLOT_BYTES), 0, SLOT_BYTES, 0x00020000);
#pragma unroll
            for (int nf = 0; nf < 2; ++nf)
#pragma unroll
                for (int mp = 0; mp < 2; ++mp) { const v2u u0 = __builtin_amdgcn_raw_buffer_load_b64(r, SL_UT + ((32 * w + 16 * nf + fr) * 64 + 16 * (2 * mp) + 4 * fq) * 2, 0, 16), u1 = __builtin_amdgcn_raw_buffer_load_b64(r, SL_UT + ((32 * w + 16 * nf + fr) * 64 + 16 * (2 * mp + 1) + 4 * fq) * 2, 0, 16);
                    R[16 + 2 * nf + mp] = (v4u){u0.x, u0.y, u1.x, u1.y}; }
            R[20].x = __builtin_amdgcn_raw_buffer_load_b32(r, SL_MISC, 0, 16); }
#define SB_() __builtin_amdgcn_sched_barrier(0)
#define LDF272(dst, base, m0) do { _Pragma("unroll") for (int ks = 0; ks < 4; ++ks) dst[ks] = *(const LAS bf16x8*)(L + (base) + (16 * (m0) + fr) * 288 + (32 * ks + 8 * fq) * 2); } while (0)
#define LDF144(dst, base, r0) do { _Pragma("unroll") for (int mm = 0; mm < 2; ++mm) _Pragma("unroll") for (int kc = 0; kc < 2; ++kc) dst[mm * 2 + kc] = *(const LAS bf16x8*)(L + (base) + (16 * ((r0) + mm) + fr) * 160 + (32 * kc + 8 * fq) * 2); } while (0)
#define MM4(acc, fr_) do { _Pragma("unroll") for (int ks = 0; ks < 4; ++ks) { acc[0] = MFMA16(fr_[ks], Sb[ks][0], acc[0]); acc[1] = MFMA16(fr_[ks], Sb[ks][1], acc[1]); } } while (0)
#define MM22(a0, a1, fr_) do { _Pragma("unroll") for (int kc = 0; kc < 2; ++kc) { a0[0] = MFMA16(fr_[kc], Vb[kc][0], a0[0]); a0[1] = MFMA16(fr_[kc], Vb[kc][1], a0[1]); a1[0] = MFMA16(fr_[2 + kc], Vb[kc][0], a1[0]); a1[1] = MFMA16(fr_[2 + kc], Vb[kc][1], a1[1]); } } while (0)
#define MMS(f0, fr_) do { _Pragma("unroll") for (int ff = 0; ff < 2; ++ff) _Pragma("unroll") for (int nf = 0; nf < 2; ++nf) { f32x4 a_ = AS_F4(R[2 * ((f0) + ff) + nf]) * dl; _Pragma("unroll") for (int kc = 0; kc < 2; ++kc) a_ = MFMA16(fr_[2 * ff + kc], Vb[kc][nf], a_); R[2 * ((f0) + ff) + nf] = AS_U4(a_); } } while (0)
        bf16x8 fa[4], fb[4];
        LDF272(fa, SC_W, 0); LDF272(fb, SC_W, 1); SB_();
        MM4(vn[0], fa); SB_(); LDF272(fa, SC_W, 2); SB_();
        MM4(vn[1], fb); SB_(); LDF272(fb, SC_W, 3); SB_();
        MM4(vn[2], fa); SB_(); LDF272(fa, SC_Q, 0); SB_();
        MM4(vn[3], fb); SB_(); LDF272(fb, SC_Q, 1); SB_();
        MM4(o[0], fa); SB_(); LDF272(fa, SC_Q, 2); SB_();
        MM4(o[1], fb); SB_(); LDF272(fb, SC_Q, 3); SB_();
        MM4(o[2], fa); SB_(); LDF144(fa, SC_QK, 0); SB_();
        MM4(o[3], fb); SB_(); LDF144(fb, SC_QK, 2);
        bf16x8 Vb[2][2];
#pragma unroll
        for (int kc = 0; kc < 2; ++kc)
#pragma unroll
            for (int nf = 0; nf < 2; ++nf) Vb[kc][nf] = mk8(pk4(vn[2 * kc][nf]), pk4(vn[2 * kc + 1][nf]));
        SB_();
        MM22(o[0], o[1], fa); SB_(); LDF144(fa, SC_K, 0); SB_();
        MM22(o[2], o[3], fb); SB_(); LDF144(fb, SC_K, 2); SB_();
        MMS(0, fa); SB_(); LDF144(fa, SC_K, 4); SB_();
        MMS(2, fb); SB_(); LDF144(fb, SC_K, 6); SB_();
        MMS(4, fa); SB_();
        MMS(6, fb); SB_();
#undef SB_
#undef LDF272
#undef LDF144
#undef MM4
#undef MM22
#undef MMS
        LAS float* ot = (LAS float*)(L + SC_O + (n & 1) * SC_OSZ);
#pragma unroll
        for (int m = 0; m < 4; ++m)
#pragma unroll
            for (int nf = 0; nf < 2; ++nf)
#pragma unroll
                for (int r = 0; r < 4; ++r) ot[(16 * m + 4 * fq + r) * 132 + 32 * w + 16 * nf + fr] = o[m][nf][r];
    }
    LDS_WAIT(); __builtin_amdgcn_s_barrier(); asm volatile("" ::: "memory");
}
template <bool WRITE>
__device__ __forceinline__ void delta_scan(Frame& F, int l, int bh) {
    const int b = bh >> 2, h = bh & 3; const int w = F.wave;
    bf16* ocat = (bf16*)(F.A->ws + WS_OCAT);
    gu32* flags = (gu32*)(F.A->ws + WS_CTL) + CW_FLAG + (size_t)((l * 32 + bh) * 32) * 16; gu32* tmo = (gu32*)(F.A->ws + WS_CTL) + CW_BAR + XB_TMO;
    const unsigned char* slot0 = F.A->ws + WS_RING + (size_t)(bh * NCH) * SLOT_BYTES;
    v4u R[22]; unsigned fnext = 0u;
#pragma unroll
    for (int i = 0; i < 22; ++i) R[i] = (v4u){0u, 0u, 0u, 0u};
    { int lane_ = F.lane; asm volatile("" : "+v"(lane_)); const int lane = lane_, tid = w * 64 + lane, fr = lane & 15, fq = lane >> 4, it = tid - 256;
      if (tid < 128) ((LAS float*)(F.lds + SC_OG))[tid] = F.A->in[6][l * 128 + tid];
      if (w == 4) scan_spin(flags, tmo);
      __syncthreads();
      if (w >= 4) { bf16* zrow = ocat + (size_t)(b * T + (it >> 2)) * D + h * 128 + 32 * (it & 3); io_load<0>(R, slot0, zrow, it); }
      else { const __amdgpu_buffer_rsrc_t r = __builtin_amdgcn_make_buffer_rsrc((void*)slot0, 0, SLOT_BYTES, 0x00020000);
#pragma unroll
          for (int nf = 0; nf < 2; ++nf)
#pragma unroll
              for (int mp = 0; mp < 2; ++mp) { const v2u u0 = __builtin_amdgcn_raw_buffer_load_b64(r, SL_UT + ((32 * w + 16 * nf + fr) * 64 + 16 * (2 * mp) + 4 * fq) * 2, 0, 16), u1 = __builtin_amdgcn_raw_buffer_load_b64(r, SL_UT + ((32 * w + 16 * nf + fr) * 64 + 16 * (2 * mp + 1) + 4 * fq) * 2, 0, 16);
                  R[16 + 2 * nf + mp] = (v4u){u0.x, u0.y, u1.x, u1.y}; }
          R[20].x = __builtin_amdgcn_raw_buffer_load_b32(r, SL_MISC, 0, 16); } }
#pragma unroll 1
    for (int n = 0; n < NCH; ++n) scan_step<WRITE, 0>(F, n, R, fnext, flags, tmo, slot0, ocat, b, h);
    { int lane_ = F.lane; asm volatile("" : "+v"(lane_)); const int it = (w - 4) * 64 + lane_;
      if (w >= 4) io_finalize<WRITE>(F.lds, (NCH - 1) & 1, R, ocat + (size_t)(b * T + (NCH - 1) * CH + (it >> 2)) * D + h * 128 + 32 * (it & 3), it); }
    __syncthreads();
}

template <bool WRITE>
__device__ __forceinline__ void gmlp_item(Frame& F, int l, int item) {
    const int g = item & 3, n = (item >> 2) & 15, b = item >> 6; const int R0 = b * T + n * GMC;
    const bf16* vg = (const bf16*)(F.A->ws + WS_VG); bf16* ocat = (bf16*)(F.A->ws + WS_OCAT); const bf16* wsb = layer_w(F.A->ws, l).wsb + (size_t)g * 128 * 128;
    const float* lng = F.A->in[7] + l * 512 + g * 128; const float* lnb = F.A->in[8] + l * 512 + g * 128; const float* bs = F.A->in[10] + (size_t)l * 512 + g * 128;
    LAS unsigned char* L = F.lds; int lane_ = F.lane; asm volatile("" : "+v"(lane_)); const int lane = lane_, w = F.wave, fr = lane & 15, fq = lane >> 4;
    { const int ch = 2 * lane; const float g0 = lng[ch], g1 = lng[ch + 1], b0 = lnb[ch], b1 = lnb[ch + 1]; float y0[16], y1[16];
#pragma unroll
      for (int i = 0; i < 16; ++i) { const unsigned u = *(const GAS unsigned*)(vg + (size_t)(R0 + 16 * w + i) * 512 + g * 128 + ch); const float a0 = bf_lo(u), a1 = bf_hi(u);
          const float mu = wave_sum(a0 + a1) * (1.0f / 128.0f); const float d0 = a0 - mu, d1 = a1 - mu; const float var = wave_sum(d0 * d0 + d1 * d1) * (1.0f / 128.0f); const float rs = 1.0f / sqrtf(var + 1e-6f);
          y0[i] = d0 * rs * g0 + b0; y1[i] = d1 * rs * g1 + b1; }
      *(LAS v4u*)(L + ch * 272 + 32 * w) = (v4u){pk2(y0[0], y0[1]), pk2(y0[2], y0[3]), pk2(y0[4], y0[5]), pk2(y0[6], y0[7])};
      *(LAS v4u*)(L + ch * 272 + 32 * w + 16) = (v4u){pk2(y0[8], y0[9]), pk2(y0[10], y0[11]), pk2(y0[12], y0[13]), pk2(y0[14], y0[15])};
      *(LAS v4u*)(L + (ch + 1) * 272 + 32 * w) = (v4u){pk2(y1[0], y1[1]), pk2(y1[2], y1[3]), pk2(y1[4], y1[5]), pk2(y1[6], y1[7])};
      *(LAS v4u*)(L + (ch + 1) * 272 + 32 * w + 16) = (v4u){pk2(y1[8], y1[9]), pk2(y1[10], y1[11]), pk2(y1[12], y1[13]), pk2(y1[14], y1[15])}; }
    LDS_WAIT(); __syncthreads();
    const int t = 16 * w + fr; const int nks = (16 * w + 15) / 32 + 1;
    bf16x8 wf[4];
#pragma unroll
    for (int ks = 0; ks < 4; ++ks) wf[ks] = (ks < nks) ? *(const GAS bf16x8*)(wsb + (size_t)t * 128 + 32 * ks + 8 * fq) : (bf16x8){0, 0, 0, 0, 0, 0, 0, 0};
    const float bst = bs[t];
#pragma unroll
    for (int nf = 0; nf < 8; ++nf) { f32x4 acc = (f32x4){0.f, 0.f, 0.f, 0.f};
#pragma unroll
        for (int ks = 0; ks < 4; ++ks) if (ks < nks) { const bf16x8 vf = *(const LAS bf16x8*)(L + (16 * nf + fr) * 272 + (32 * ks + 8 * fq) * 2); acc = MFMA16(vf, wf[ks], acc); }
        bf16* up = ocat + (size_t)(R0 + t) * D + 512 + g * 128 + 16 * nf + 4 * fq; const v2u u = *(const GAS v2u*)up;
        v2u o; o.x = pk2(bf_lo(u.x) * (acc[0] + bst), bf_hi(u.x) * (acc[1] + bst)); o.y = pk2(bf_lo(u.y) * (acc[2] + bst), bf_hi(u.y) * (acc[3] + bst));
        if (WRITE) *(GAS v2u*)up = o; else asm volatile("" :: "v"(o.x), "v"(o.y)); }
    __syncthreads();
}

__device__ __forceinline__ void final_norm(Frame& F) {
    const int gw = F.vcu * NWAVES + F.wave, NGW = F.G * NWAVES; const float* ssq = (const float*)(F.A->ws + WS_SSQ); const float* gn = F.A->in[16]; const bf16* hb = (const bf16*)(F.A->ws + WS_HB);
    f32x4 gv[4];
#pragma unroll
    for (int j = 0; j < 4; ++j) gv[j] = *(const GAS f32x4*)(gn + 4 * F.lane + 256 * j);
    for (int m = gw; m < M; m += NGW) { const float rs = pg8::row_rs(ssq, m); GAS f32x4* xr = (GAS f32x4*)(F.A->out + (size_t)m * D) + F.lane; const GAS v2u* hr = (const GAS v2u*)(hb + (size_t)m * D) + F.lane;
#pragma unroll
        for (int j = 0; j < 4; ++j) { const v2u h2 = hr[64 * j]; f32x4 v = (f32x4){bf_lo(h2.x), bf_hi(h2.x), bf_lo(h2.y), bf_hi(h2.y)}; v = v * rs * gv[j]; xr[64 * j] = v; } }
}

__global__ void __launch_bounds__(NWAVES * 64, 2) hyb_fwd(Args args) {
    extern __shared__ __attribute__((aligned(16))) unsigned char lds[];
    Frame F;
    F.lds = (LAS unsigned char*)lds;
    F.tid = threadIdx.x; F.lane = F.tid & 63; F.wave = __builtin_amdgcn_readfirstlane(F.tid >> 6);
    const int wave0 = F.wave;
    F.G = gridDim.x; { const int bx = blockIdx.x; F.vcu = (F.G % 8 == 0) ? (bx % 8) * (F.G / 8) + bx / 8 : bx; }
    F.A = (const CAS Args*)__builtin_amdgcn_kernarg_segment_ptr();
    gu32* ctl = (gu32*)(args.ws + WS_CTL);
    volatile LAS unsigned* MISC = (volatile LAS unsigned*)(F.lds + MISC_OFF);
    for (int u = F.tid; u < 1024 / 4; u += NWAVES * 64) ((LAS unsigned*)(F.lds + CTL_OFF))[u] = 0u;
    __syncthreads();
    const int lo = args.ph_lo, hi = args.ph_hi;
    const bool multi = (hi - lo) > 1;
    XcdBarrier bar; bar.bar = (unsigned*)(ctl + CW_BAR); bar.x = 0; bar.st = nullptr;
    if (multi) bar = xcd_barrier_post((unsigned*)(ctl + CW_BAR), MISC + 8);
#define RELAUNDER() do { int t_ = wave0 * 64 + (int)__builtin_amdgcn_mbcnt_hi(~0u, __builtin_amdgcn_mbcnt_lo(~0u, 0u)); asm volatile("" : "+v"(t_)); F.tid = t_; F.lane = t_ & 63; F.wave = wave0; const CAS Args* a_ = (const CAS Args*)__builtin_amdgcn_kernarg_segment_ptr(); asm volatile("" : "+s"(a_)); F.A = a_; } while (0)
#define IN(k) (lo <= (k) && (k) < hi)
#ifdef PROBE_BARX
#define SEAM(k) do { if (IN(k) && IN((k) + 1)) { xcd_barrier(bar, wave0); xcd_barrier(bar, wave0); xcd_barrier(bar, wave0); } } while (0)
#else
#define SEAM(k) do { if (IN(k) && IN((k) + 1)) xcd_barrier(bar, wave0); } while (0)
#endif
#define WSP(off) (F.A->ws + (off))
#ifndef NO_P0
    if (IN(0)) { RELAUNDER(); p0_prologue(F);
#ifdef PROBE_P0X2
      __syncthreads(); p0_prologue(F);
#endif
    }
#endif
    SEAM(0);
#pragma unroll 1
    for (int l = 0; l < DEPTH; ++l) { const int pb = 1 + 5 * l;
        if (IN(pb)) {
            RELAUNDER();
#ifndef NO_G1
            { pg8::Gemm g{(bf16*)WSP(WS_HB), layer_w(F.A->ws, l).win, M, NPROJ, D}; pg8::StaticOrder S; S.init(M, NPROJ, F.G, (int)blockIdx.x);
              pg8::EpiProj E{(bf16*)WSP(WS_QKV), (bf16*)WSP(WS_OCAT), (bf16*)WSP(WS_VG), (const float*)WSP(WS_SSQ)};
              pg8::gemm_phase<pg8::EpiProj, pg8::StaticOrder, true, true>(F.lds, g, S, E, wave0);
#ifdef PROBE_G1X2
              pg8::gemm_phase<pg8::EpiProj, pg8::StaticOrder, true, true>(F.lds, g, S, E, wave0);
#endif
            }
#endif
#ifndef NO_BA
            RELAUNDER();
            for (int r0 = 64 * (int)blockIdx.x; r0 < M; r0 += 64 * F.G) ba_rows(F, l, r0);
#endif
        } SEAM(pb);
        if (IN(pb + 1)) {
            RELAUNDER();
            if ((int)blockIdx.x < 32) {
#ifndef NO_DELTA
#ifdef PROBE_SCAN2
                delta_scan<false>(F, l, (int)blockIdx.x);
#endif
                delta_scan<true>(F, l, (int)blockIdx.x);
#endif
            } else { const int p = (int)blockIdx.x - 32, np = F.G - 32;
#ifndef NO_DELTA
#pragma unroll 1
                for (int j = p; j < 32 * NCH; j += np) { const int bh = j & 31, n = j >> 5;
                    delta_prep_item(F, l, bh >> 2, bh & 3, n, F.A->ws + WS_RING + (size_t)(bh * NCH + n) * SLOT_BYTES, (gu32*)(F.A->ws + WS_CTL) + CW_FLAG + (size_t)((l * 32 + bh) * 32 + n) * 16); }
#endif
#ifndef NO_GMLP
#pragma unroll 1
#ifdef PROBE_GMLP2
                for (int it = p; it < 512; it += np) gmlp_item<false>(F, l, it);
#endif
                for (int it = p; it < 512; it += np) gmlp_item<true>(F, l, it);
#endif
                if (l == 0) { __syncthreads(); p0_weights(F, true, p * NWAVES + F.wave, np * NWAVES); }
            }
        } SEAM(pb + 1);
        if (IN(pb + 2)) {
            RELAUNDER();
#ifndef NO_G2
            pg8::Gemm g{(bf16*)WSP(WS_OCAT), layer_w(F.A->ws, l).wout, M, D, D}; pg8::StaticOrder S; S.init(M, D, F.G, (int)blockIdx.x);
            pg8::EpiRes E{(bf16*)WSP(WS_HB), (float*)WSP(WS_SSQ)};
            pg8::gemm_phase<pg8::EpiRes, pg8::StaticOrder, false, true>(F.lds, g, S, E, wave0);
#ifdef PROBE_G2X2
            if (l == 0) pg8::gemm_phase<pg8::EpiRes, pg8::StaticOrder, false, true>(F.lds, g, S, E, wave0);
#endif
#endif
        } SEAM(pb + 2);
        if (IN(pb + 3)) {
            RELAUNDER();
#ifndef NO_G3
            pg8::Gemm g{(bf16*)WSP(WS_HB), layer_w(F.A->ws, l).wgu, M, NGU, D}; pg8::StaticOrder S; S.init(M, NGU, F.G, (int)blockIdx.x);
            pg8::EpiSwiglu E{(bf16*)WSP(WS_HID), (const float*)WSP(WS_SSQ)};
            pg8::gemm_phase<pg8::EpiSwiglu, pg8::StaticOrder, true, true>(F.lds, g, S, E, wave0);
#ifdef PROBE_G3X2
            pg8::gemm_phase<pg8::EpiSwiglu, pg8::StaticOrder, true, true>(F.lds, g, S, E, wave0);
#endif
#endif
        } SEAM(pb + 3);
        if (IN(pb + 4)) {
            RELAUNDER();
#ifndef NO_G4
            pg8::Gemm g{(bf16*)WSP(WS_HID), layer_w(F.A->ws, l).wdn, M, D, DFF}; pg8::StaticOrder S; S.init(M, D, F.G, (int)blockIdx.x);
            pg8::EpiRes E{(bf16*)WSP(WS_HB), (float*)WSP(WS_SSQ)};
            pg8::gemm_phase<pg8::EpiRes, pg8::StaticOrder, false, true>(F.lds, g, S, E, wave0);
#endif
        } SEAM(pb + 4);
    }
#ifndef NO_FN
    if (IN(11)) { RELAUNDER(); final_norm(F); }
#endif
#undef IN
#undef SEAM
}

extern "C" void kernel_launch(void* const* d_in, const int* in_sizes, int n_in, void* d_out, int out_size, void* d_ws, size_t ws_size, hipStream_t stream) {
    static int grid = 0;
    if (grid == 0) {
        if (n_in != 17 || in_sizes[0] != M * D || out_size != M * D || ws_size < WS_END) { fprintf(stderr, "kernel_launch: unexpected shapes (n_in %d, in0 %d, out %d, ws %zu < %zu)\n", n_in, n_in > 0 ? in_sizes[0] : -1, out_size, ws_size, (size_t)WS_END); grid = -1; return; }
        int dev = 0, cus = 0, per_cu = 0;
        if (hipGetDevice(&dev) != hipSuccess || hipDeviceGetAttribute(&cus, hipDeviceAttributeMultiprocessorCount, dev) != hipSuccess) { grid = -1; return; }
        if (hipFuncSetAttribute((const void*)hyb_fwd, hipFuncAttributeMaxDynamicSharedMemorySize, LDS_BYTES) != hipSuccess) { fprintf(stderr, "kernel_launch: hipFuncSetAttribute failed\n"); grid = -1; return; }
        if (hipOccupancyMaxActiveBlocksPerMultiprocessor(&per_cu, (const void*)hyb_fwd, NWAVES * 64, LDS_BYTES) != hipSuccess || per_cu < 1) { fprintf(stderr, "kernel_launch: occupancy query says %d blocks per CU\n", per_cu); per_cu = 1; }
        (void)hipGetLastError();
        grid = cus;
    }
    if (grid < 0) return;
    (void)hipMemsetAsync((char*)d_ws + WS_CTL, 0, CTL_BYTES, stream);
    Args a{};
    for (int i = 0; i < 17; ++i) a.in[i] = (const float*)d_in[i];
    a.out = (float*)d_out; a.ws = (unsigned char*)d_ws;
    if (MK_N_LAUNCHES == 1) {
        a.ph_lo = 0; a.ph_hi = N_PHASES;
        void* params[] = {&a};
        hipError_t e = hipLaunchCooperativeKernel((const void*)hyb_fwd, dim3(grid), dim3(NWAVES * 64), params, LDS_BYTES, stream);
        if (e != hipSuccess) fprintf(stderr, "kernel_launch: cooperative launch failed: %s (grid %d)\n", hipGetErrorString(e), grid);
    } else {
        for (int p = 0; p < N_PHASES; ++p) { a.ph_lo = p; a.ph_hi = p + 1; hipLaunchKernelGGL(hyb_fwd, dim3(grid), dim3(NWAVES * 64), LDS_BYTES, stream, a); }
    }
}
```
